# Optimizing an MI355X kernel written in HIP

```python
import math
import jax, jax.numpy as jnp
from jax import lax
import numpy as np

D_MODEL = 1024
BATCH = 8
SEQ = 4096
DEPTH = 2

N_META = 16
EPS = 1e-6
A_HEADS = 4
A_WIDTH = D_MODEL
A_HEAD_DIM = A_WIDTH // A_HEADS
A_CHUNK = 64
B_WIDTH = D_MODEL
B_BLOCKS = 8
B_BLOCK_DIM = B_WIDTH // B_BLOCKS
B_CONV = 4
LRU_C = 8.0
C_HEADS = D_MODEL // 128
C_QK_DIM = D_MODEL // (2 * C_HEADS)
C_V_DIM = 2 * C_QK_DIM
ROT_DIM = C_QK_DIM // 4
ROPE_THETA = 500000.0
Q_BLOCK = 128
D_FF = 4 * D_MODEL
N_AB = (DEPTH + 1) // 2
N_C = DEPTH // 2
AB_SPLITS = [A_WIDTH, A_WIDTH, A_WIDTH, A_WIDTH, A_HEADS, A_HEADS, B_WIDTH, B_WIDTH]
AB_IN = sum(AB_SPLITS)
C_SPLITS = [C_HEADS * 2 * C_QK_DIM, C_HEADS * 2 * C_QK_DIM, C_HEADS * C_V_DIM]
C_IN = sum(C_SPLITS)

kernel_name = "hybrid_mlstm_rglru_diffattn_trunk"


def _rmsnorm(x, g):
    xf = x.astype(jnp.float32)
    y = xf * lax.rsqrt(jnp.mean(xf * xf, axis=-1, keepdims=True) + EPS)
    return (y * g.astype(jnp.float32)).astype(x.dtype)


def _split(a, sizes):
    return jnp.split(a, np.cumsum(sizes)[:-1].tolist(), axis=-1)


def _mlstm_chunk(state, inp):
    c_mem, n_mem, m_prev = state
    q, k, v, log_i, log_f = inp
    L = q.shape[2]
    b = jnp.cumsum(log_f, axis=-1)
    causal = jnp.tril(jnp.ones((L, L), dtype=bool))
    log_d = b[..., :, None] - b[..., None, :] + log_i[..., None, :]
    log_d = jnp.where(causal, log_d, -jnp.inf)
    log_prev = b + m_prev[..., None]
    m_t = jnp.maximum(log_prev, jnp.max(log_d, axis=-1))
    d = jnp.exp(log_d - m_t[..., None])
    w_prev = jnp.exp(log_prev - m_t)
    s = jnp.einsum('bhtd,bhsd->bhts', q, k) * d
    num = (w_prev[..., None] * jnp.einsum('bhvk,bhtk->bhtv', c_mem, q)
           + jnp.einsum('bhts,bhsv->bhtv', s, v))
    den = w_prev * jnp.einsum('bhk,bhtk->bht', n_mem, q) + jnp.sum(s, axis=-1)
    h = num / jnp.maximum(jnp.abs(den), jnp.exp(-m_t))[..., None]
    log_end = b[..., -1:] - b + log_i
    m_new = jnp.maximum(b[..., -1] + m_prev, jnp.max(log_end, axis=-1))
    w_s = jnp.exp(log_end - m_new[..., None])
    decay = jnp.exp(b[..., -1] + m_prev - m_new)
    c_new = decay[..., None, None] * c_mem + jnp.einsum('bhs,bhsv,bhsk->bhvk', w_s, v, k)
    n_new = decay[..., None] * n_mem + jnp.einsum('bhs,bhsk->bhk', w_s, k)
    return (c_new, n_new, m_new), h


def _mlstm(q, k, v, i_pre, f_pre):
    bsz, t_all, nh, dh = q.shape
    seq = t_all - N_META
    nc = seq // A_CHUNK
    q = q.transpose(0, 2, 1, 3)
    k = k.transpose(0, 2, 1, 3) * (dh ** -0.5)
    v = v.transpose(0, 2, 1, 3)
    log_i = i_pre.transpose(0, 2, 1)
    log_f = jax.nn.log_sigmoid(f_pre).transpose(0, 2, 1)
    state = (jnp.zeros((bsz, nh, dh, dh), jnp.float32),
             jnp.zeros((bsz, nh, dh), jnp.float32),
             jnp.zeros((bsz, nh), jnp.float32))
    state, h_meta = _mlstm_chunk(
        state, (q[:, :, :N_META], k[:, :, :N_META], v[:, :, :N_META],
                log_i[:, :, :N_META], log_f[:, :, :N_META]))

    def chunks(a):
        a = a[:, :, N_META:]
        return jnp.moveaxis(a.reshape(bsz, nh, nc, A_CHUNK, *a.shape[3:]), 2, 0)

    _, h_rest = lax.scan(_mlstm_chunk, state,
                         (chunks(q), chunks(k), chunks(v), chunks(log_i), chunks(log_f)))
    h_rest = jnp.moveaxis(h_rest, 0, 2).reshape(bsz, nh, seq, dh)
    h = jnp.concatenate([h_meta, h_rest], axis=2)
    return h.transpose(0, 2, 1, 3)


def _rg_lru_branch(xb, gate, conv_w, conv_b, w_r, b_r, w_i, b_i, lam):
    bsz, t_all, w = xb.shape
    xc = lax.conv_general_dilated(
        xb.astype(jnp.float32), conv_w.astype(jnp.float32)[:, None, :],
        window_strides=(1,), padding=[(B_CONV - 1, 0)],
        dimension_numbers=('NWC', 'WIO', 'NWC'), feature_group_count=w)
    xc = xc + conv_b.astype(jnp.float32)
    xg = xc.reshape(bsz, t_all, B_BLOCKS, B_BLOCK_DIM)
    r = jax.nn.sigmoid(jnp.einsum('btnd,nde->btne', xg, w_r.astype(jnp.float32)).reshape(bsz, t_all, w)
                       + b_r.astype(jnp.float32))
    i = jax.nn.sigmoid(jnp.einsum('btnd,nde->btne', xg, w_i.astype(jnp.float32)).reshape(bsz, t_all, w)
                       + b_i.astype(jnp.float32))
    log_a = -LRU_C * r * jax.nn.softplus(-lam.astype(jnp.float32))
    a = jnp.exp(log_a)
    u = jnp.sqrt(-jnp.expm1(2.0 * log_a)) * (i * xc)

    def combine(left, right):
        a1, b1 = left
        a2, b2 = right
        return a1 * a2, a2 * b1 + b2

    _, h = lax.associative_scan(combine, (a, u), axis=1)
    return h * jax.nn.gelu(gate.astype(jnp.float32))


def _ab_mixer(hn, w_in, if_bias, mlstm_norm, conv_w, conv_b, w_r, b_r, w_i, b_i, lam, w_out):
    bsz, t_all, _ = hn.shape
    proj = hn @ w_in
    q, k, v, o, gi, gf, xb, gate = _split(proj, AB_SPLITS)
    f32 = jnp.float32
    hs = (bsz, t_all, A_HEADS, A_HEAD_DIM)
    ifb = if_bias.astype(f32)
    h_a = _mlstm(q.astype(f32).reshape(hs), k.astype(f32).reshape(hs), v.astype(f32).reshape(hs),
                 gi.astype(f32) + ifb[:A_HEADS], gf.astype(f32) + ifb[A_HEADS:])
    h_a = jax.nn.sigmoid(o.astype(f32)).reshape(hs) * h_a
    h_a = h_a * lax.rsqrt(jnp.mean(h_a * h_a, axis=-1, keepdims=True) + EPS)
    h_a = (h_a * mlstm_norm.astype(f32).reshape(A_HEADS, A_HEAD_DIM)).reshape(bsz, t_all, A_WIDTH)
    h_b = _rg_lru_branch(xb, gate, conv_w, conv_b, w_r, b_r, w_i, b_i, lam)
    y = jnp.concatenate([h_a, h_b], axis=-1).astype(hn.dtype)
    return y @ w_out


def _partial_rope(x, cos, sin):
    half = ROT_DIM // 2
    x1, x2, rest = x[..., :half], x[..., half:ROT_DIM], x[..., ROT_DIM:]
    c = cos[:, None, None, :]
    s = sin[:, None, None, :]
    return jnp.concatenate([x1 * c - x2 * s, x2 * c + x1 * s, rest], axis=-1)


def _diff_attend(qb, q_pos, kh, vh, k_pos, lam):
    s = jnp.einsum('bhcqd,bhckd->bhcqk', qb, kh)
    mask = k_pos[None, :] <= q_pos[:, None]
    p = jax.nn.softmax(jnp.where(mask, s, -jnp.inf), axis=-1)
    pd = p[:, :, 0] - lam * p[:, :, 1]
    return jnp.einsum('bhqk,bhkv->bhqv', pd, vh)


def _diff_attn(hn, w_in, lam_vecs, subln, w_out, lambda_init):
    bsz, t_all, _ = hn.shape
    seq = t_all - N_META
    f32 = jnp.float32
    q, k, v = _split(hn @ w_in, C_SPLITS)
    q = q.astype(f32).reshape(bsz, t_all, C_HEADS, 2, C_QK_DIM)
    k = k.astype(f32).reshape(bsz, t_all, C_HEADS, 2, C_QK_DIM)
    v = v.astype(f32).reshape(bsz, t_all, C_HEADS, C_V_DIM)
    pos = jnp.arange(t_all, dtype=jnp.int32)
    inv_freq = jnp.power(jnp.float32(ROPE_THETA), -jnp.arange(0, ROT_DIM, 2, dtype=f32) / ROT_DIM)
    ang = pos.astype(f32)[:, None] * inv_freq[None, :]
    cos, sin = jnp.cos(ang), jnp.sin(ang)
    q = _partial_rope(q, cos, sin) * (C_QK_DIM ** -0.5)
    k = _partial_rope(k, cos, sin)
    lv = lam_vecs.astype(f32)
    lam = jnp.exp(jnp.sum(lv[0] * lv[1])) - jnp.exp(jnp.sum(lv[2] * lv[3])) + lambda_init
    qh = q.transpose(0, 2, 3, 1, 4)
    kh = k.transpose(0, 2, 3, 1, 4)
    vh = v.transpose(0, 2, 1, 3)
    o_meta = _diff_attend(qh[:, :, :, :N_META], pos[:N_META], kh[:, :, :, :N_META],
                          vh[:, :, :N_META], pos[:N_META], lam)
    nb = seq // Q_BLOCK
    q_blocks = jnp.moveaxis(qh[:, :, :, N_META:].reshape(bsz, C_HEADS, 2, nb, Q_BLOCK, C_QK_DIM), 3, 0)
    pos_blocks = pos[N_META:].reshape(nb, Q_BLOCK)
    o_rest = lax.map(lambda a: _diff_attend(a[0], a[1], kh, vh, pos, lam), (q_blocks, pos_blocks))
    o_rest = jnp.moveaxis(o_rest, 0, 2).reshape(bsz, C_HEADS, seq, C_V_DIM)
    o = jnp.concatenate([o_meta, o_rest], axis=2)
    o = o * lax.rsqrt(jnp.mean(o * o, axis=-1, keepdims=True) + EPS) * subln.astype(f32)
    o = o * (1.0 - lambda_init)
    o = o.transpose(0, 2, 1, 3).reshape(bsz, t_all, C_HEADS * C_V_DIM).astype(hn.dtype)
    return o @ w_out


def _sq_relu_mlp(hn, w1, w2):
    a = jax.nn.relu(hn @ w1)
    return (a * a) @ w2


def setup_inputs(seed: int = 0) -> dict:
    key = jax.random.key(seed)
    ks = jax.random.split(key, 24)
    f32 = jnp.float32

    def nrm(k, shape, scale):
        return jax.random.normal(k, shape, f32) * scale

    x = nrm(ks[0], (BATCH, SEQ, D_MODEL), 1.0)
    meta_tokens = nrm(ks[1], (N_META, D_MODEL), 1.0)
    norm_mix = 1.0 + nrm(ks[2], (DEPTH, D_MODEL), 0.05)
    norm_mlp = 1.0 + nrm(ks[3], (DEPTH, D_MODEL), 0.05)
    norm_final = 1.0 + nrm(ks[4], (D_MODEL,), 0.05)
    ab_w_in = nrm(ks[5], (N_AB, D_MODEL, AB_IN), D_MODEL ** -0.5)
    i_b = -1.0 + nrm(ks[6], (N_AB, A_HEADS), 0.1)
    f_b = jnp.linspace(3.0, 6.0, A_HEADS, dtype=f32)[None, :] + nrm(ks[7], (N_AB, A_HEADS), 0.1)
    ab_if_bias = jnp.concatenate([i_b, f_b], axis=-1)
    mlstm_norm = 1.0 + nrm(ks[8], (N_AB, A_WIDTH), 0.05)
    lru_conv_w = nrm(ks[9], (N_AB, B_CONV, B_WIDTH), B_CONV ** -0.5)
    lru_conv_b = nrm(ks[10], (N_AB, B_WIDTH), 0.01)
    lru_w_r = nrm(ks[11], (N_AB, B_BLOCKS, B_BLOCK_DIM, B_BLOCK_DIM), B_BLOCK_DIM ** -0.5)
    lru_b_r = nrm(ks[12], (N_AB, B_WIDTH), 0.01)
    lru_w_i = nrm(ks[13], (N_AB, B_BLOCKS, B_BLOCK_DIM, B_BLOCK_DIM), B_BLOCK_DIM ** -0.5)
    lru_b_i = nrm(ks[14], (N_AB, B_WIDTH), 0.01)
    u = jax.random.uniform(ks[15], (N_AB, B_WIDTH), f32, 0.9, 0.999)
    p = u ** (1.0 / LRU_C)
    lru_lambda = jnp.log(p) - jnp.log1p(-p)
    ab_w_out = nrm(ks[16], (N_AB, A_WIDTH + B_WIDTH, D_MODEL), (A_WIDTH + B_WIDTH) ** -0.5)
    c_w_in = nrm(ks[17], (N_C, D_MODEL, C_IN), D_MODEL ** -0.5)
    c_lambda = nrm(ks[18], (N_C, 4, C_QK_DIM), 0.1)
    c_subln = 1.0 + nrm(ks[19], (N_C, C_V_DIM), 0.05)
    c_w_out = nrm(ks[20], (N_C, C_HEADS * C_V_DIM, D_MODEL), (C_HEADS * C_V_DIM) ** -0.5)
    mlp_w1 = nrm(ks[21], (DEPTH, D_MODEL, D_FF), D_MODEL ** -0.5)
    mlp_w2 = nrm(ks[22], (DEPTH, D_FF, D_MODEL), D_FF ** -0.5)
    return {"x": x, "meta_tokens": meta_tokens, "norm_mix": norm_mix, "norm_mlp": norm_mlp,
            "norm_final": norm_final, "ab_w_in": ab_w_in, "ab_if_bias": ab_if_bias,
            "mlstm_norm": mlstm_norm, "lru_conv_w": lru_conv_w, "lru_conv_b": lru_conv_b,
            "lru_w_r": lru_w_r, "lru_b_r": lru_b_r, "lru_w_i": lru_w_i, "lru_b_i": lru_b_i,
            "lru_lambda": lru_lambda, "ab_w_out": ab_w_out, "c_w_in": c_w_in,
            "c_lambda": c_lambda, "c_subln": c_subln, "c_w_out": c_w_out,
            "mlp_w1": mlp_w1, "mlp_w2": mlp_w2}


def reference(x, meta_tokens, norm_mix, norm_mlp, norm_final, ab_w_in, ab_if_bias,
              mlstm_norm, lru_conv_w, lru_conv_b, lru_w_r, lru_b_r, lru_w_i, lru_b_i,
              lru_lambda, ab_w_out, c_w_in, c_lambda, c_subln, c_w_out, mlp_w1, mlp_w2):
    bsz = x.shape[0]
    meta = jnp.broadcast_to(meta_tokens[None].astype(x.dtype), (bsz, N_META, x.shape[-1]))
    h = jnp.concatenate([meta, x], axis=1)
    for layer in range(DEPTH):
        j = layer // 2
        hn = _rmsnorm(h, norm_mix[layer])
        if layer % 2 == 0:
            h = h + _ab_mixer(hn, ab_w_in[j], ab_if_bias[j], mlstm_norm[j], lru_conv_w[j],
                              lru_conv_b[j], lru_w_r[j], lru_b_r[j], lru_w_i[j], lru_b_i[j],
                              lru_lambda[j], ab_w_out[j])
        else:
            lambda_init = 0.8 - 0.6 * math.exp(-0.3 * layer)
            h = h + _diff_attn(hn, c_w_in[j], c_lambda[j], c_subln[j], c_w_out[j], lambda_init)
        h = h + _sq_relu_mlp(_rmsnorm(h, norm_mlp[layer]), mlp_w1[layer], mlp_w2[layer])
    h = _rmsnorm(h, norm_final)
    return h[:, N_META:, :]
```

```cpp
#include <hip/hip_runtime.h>
#include <hip/hip_cooperative_groups.h>
#include <cstdio>
#include <cstdint>
namespace cg = cooperative_groups;

#define LAS __attribute__((address_space(3)))
#define DI __device__ __forceinline__
typedef unsigned short bf16_t;
typedef short bf16x8 __attribute__((ext_vector_type(8)));
typedef short bf16x4 __attribute__((ext_vector_type(4)));
typedef float f32x4 __attribute__((ext_vector_type(4)));
typedef float f32x2 __attribute__((ext_vector_type(2)));
typedef float f32x16 __attribute__((ext_vector_type(16)));
typedef unsigned u32x4 __attribute__((ext_vector_type(4)));
typedef unsigned u32x2 __attribute__((ext_vector_type(2)));
typedef __bf16 hbf2 __attribute__((ext_vector_type(2)));

constexpr int MR = 32768;
constexpr int MV = 32896;
constexpr int MP = 33024;
constexpr int TSEQ = 4112;
constexpr float EPS = 1e-6f;
constexpr float LAMBDA_INIT = 0.35550906759096934f;
constexpr float LOG2E = 1.4426950408889634f;

constexpr size_t OFF_WIN0 = 0;
constexpr size_t OFF_WOUT0 = OFF_WIN0 + 6144ull * 1024 * 2;
constexpr size_t OFF_WM10 = OFF_WOUT0 + 1024ull * 2048 * 2;
constexpr size_t OFF_WM20 = OFF_WM10 + 4096ull * 1024 * 2;
constexpr size_t OFF_WIN1 = OFF_WM20 + 4096ull * 1024 * 2;
constexpr size_t OFF_WOUT1 = OFF_WIN1 + 3072ull * 1024 * 2;
constexpr size_t OFF_WM11 = OFF_WOUT1 + 1024ull * 1024 * 2;
constexpr size_t OFF_WM21 = OFF_WM11 + 4096ull * 1024 * 2;
constexpr size_t OFF_WLRU = OFF_WM21 + 4096ull * 1024 * 2;
constexpr size_t OFF_LI = OFF_WLRU + 2ull * 8 * 128 * 128 * 2;
constexpr size_t OFF_LF = OFF_LI + (size_t)MP * 16;
constexpr size_t OFF_SS = OFF_LF + (size_t)MP * 16;
constexpr size_t OFF_HSS = OFF_SS + 4ull * MP * 4;
constexpr size_t OFF_ROPE = OFF_HSS + (size_t)MP * 16;
constexpr size_t OFF_MISC = OFF_ROPE + (size_t)TSEQ * 64;
constexpr size_t OFF_BAR = OFF_MISC + 256;
constexpr size_t OFF_HB = OFF_BAR + 13824;
constexpr size_t OFF_R2 = OFF_HB + (size_t)MP * 2048;
constexpr size_t OFF_R3 = OFF_R2 + (size_t)MP * 8192;
constexpr size_t WS_END = OFF_R3 + (size_t)MP * 4096;
constexpr size_t OFF_H = OFF_R2;
constexpr size_t OFF_HID = OFF_R2 + (size_t)MP * 4096;
constexpr size_t OFF_QK1 = OFF_HID;
constexpr size_t OFF_VT = OFF_R3;
constexpr size_t OFF_AO = OFF_R3 + (size_t)MP * 2048;
static_assert(WS_END <= 536870912ull, "workspace");

constexpr int LDS_BYTES = 163840;

struct Params {
    const float *x, *meta, *norm_mix, *norm_mlp, *norm_final, *ab_w_in, *ab_if_bias, *mlstm_norm, *conv_w, *conv_b,
        *w_r, *b_r, *w_i, *b_i, *lam, *ab_w_out, *c_w_in, *c_lambda, *c_subln, *c_w_out, *mlp_w1, *mlp_w2;
    float* out;
    unsigned char* ws;
};

DI unsigned pk2(float a, float b) { f32x2 v = {a, b}; hbf2 r = __builtin_convertvector(v, hbf2); return __builtin_bit_cast(unsigned, r); }
DI bf16_t f2bf(float a) { return (bf16_t)(pk2(a, 0.f) & 0xffffu); }
DI float bf2f(bf16_t b) { return __uint_as_float(((unsigned)b) << 16); }
DI float bflo(unsigned u) { return __uint_as_float(u << 16); }
DI float bfhi(unsigned u) { return __uint_as_float(u & 0xffff0000u); }
DI float sigmoidf_(float x) { return __builtin_amdgcn_rcpf(1.0f + __expf(-x)); }
DI float gelu_tanh(float x) { const float z = 1.5957691216057308f * (x + 0.044715f * x * x * x); return x * sigmoidf_(z); }
DI int tid_fresh() { int t = threadIdx.x; asm volatile("" : "+v"(t)); return t; }
DI float sum_x32(float x) { auto r = __builtin_amdgcn_permlane32_swap(__float_as_uint(x), __float_as_uint(x), false, false); return __uint_as_float(r[0]) + __uint_as_float(r[1]); }
DI float max_x32(float x) { auto r = __builtin_amdgcn_permlane32_swap(__float_as_uint(x), __float_as_uint(x), false, false); return fmaxf(__uint_as_float(r[0]), __uint_as_float(r[1])); }
DI float sum_x16(float x) { auto r = __builtin_amdgcn_permlane16_swap(__float_as_uint(x), __float_as_uint(x), false, false); return __uint_as_float(r[0]) + __uint_as_float(r[1]); }
DI float sum_x16_x32(float x) { return sum_x32(sum_x16(x)); }

DI float wave_sum(float v) {
#pragma unroll
    for (int o = 32; o >= 1; o >>= 1) v += __shfl_xor(v, o);
    return v;
}

template <int CTRL, int ROWMASK> DI float dpp_mov(float old, float src) {
    return __builtin_bit_cast(float, __builtin_amdgcn_update_dpp(__builtin_bit_cast(int, old), __builtin_bit_cast(int, src), CTRL, ROWMASK, 0xf, false));
}
DI float wave_scan_add(float x) {
    x += dpp_mov<0x111, 0xf>(0.f, x); x += dpp_mov<0x112, 0xf>(0.f, x); x += dpp_mov<0x114, 0xf>(0.f, x); x += dpp_mov<0x118, 0xf>(0.f, x);
    x += dpp_mov<0x142, 0xa>(0.f, x); x += dpp_mov<0x143, 0xc>(0.f, x);
    return x;
}
DI float wave_scan_max(float x) {
    const float ninf = -INFINITY;
    x = fmaxf(x, dpp_mov<0x111, 0xf>(ninf, x)); x = fmaxf(x, dpp_mov<0x112, 0xf>(ninf, x)); x = fmaxf(x, dpp_mov<0x114, 0xf>(ninf, x)); x = fmaxf(x, dpp_mov<0x118, 0xf>(ninf, x));
    x = fmaxf(x, dpp_mov<0x142, 0xa>(ninf, x)); x = fmaxf(x, dpp_mov<0x143, 0xc>(ninf, x));
    return x;
}

namespace pg8 {
constexpr int BM = 256, BK = 64, HALF = 128, HTB = HALF * BK * 2, STAGE_BYTES = 8 * HTB, NXCD = 8, WGM = 8;
__host__ __device__ __forceinline__ int lds_byte(int r, int c) { const int st = (r >> 4) * 2 + (c >> 5), rr = r & 15, cc = c & 31, ob = rr * 64 + cc * 2; return st * 1024 + (ob ^ (((ob >> 9) & 1) << 5)); }
__host__ __device__ __forceinline__ void stage_rc(int b, int& R, int& C) { const int st = b / 1024, sb = b % 1024, swz = sb ^ (((sb >> 9) & 1) << 5); R = (st >> 1) * 16 + swz / 64; C = (st & 1) * 32 + (swz % 64) / 2; }
__host__ __device__ __forceinline__ int perm32(int rho) { const int n = rho >> 4, i = rho & 15; return 8 * (i >> 2) + 4 * n + (i & 3); }
struct Unit { int pm, pn; };
struct Gemm { const bf16_t* A; const bf16_t* Bt; int M, N, K; };
struct StaticOrder {
    int nM, nN, nwg, G, c;
    __device__ void init(int M, int N, int G_, int c_) { nM = M / BM; nN = N / BM; nwg = nM * nN; G = G_; c = c_; }
    __device__ bool next(int i, Unit& u) const {
        const long L = (long)i * G + c; if (L >= nwg) return false;
        int wgid = (int)L; { const int q = nwg / NXCD, r = nwg % NXCD, xcd = wgid % NXCD, off = wgid / NXCD; wgid = (xcd < r ? xcd * (q + 1) : r * (q + 1) + (xcd - r) * q) + off; }
        const int nig = WGM * nN, gid = wgid / nig, fm = gid * WGM, gsz = (nM - fm) < WGM ? (nM - fm) : WGM;
        u.pm = fm + ((wgid % nig) % gsz); u.pn = (wgid % nig) / gsz; return true;
    }
};

template <class Epi>
__device__ __forceinline__ void gemm_phase(LAS unsigned char* lds, const Gemm g, const StaticOrder& S, const Epi& E) {
    const int tid = tid_fresh(), wid = __builtin_amdgcn_readfirstlane(tid >> 6), lane = tid & 63, wr = wid >> 2, wc = wid & 3, fr = lane & 15, fq = lane >> 4;
    const int K = g.K, nt = K / BK;
    unsigned voffA[2], voffB[2];
#pragma unroll
    for (int i = 0; i < 2; ++i) { int R, C; stage_rc(tid * 16 + i * 8192, R, C); const int Rb = Epi::PERM ? ((R & ~31) + perm32(R & 31)) : R;
        voffA[i] = (unsigned)(R * K + C) * 2u; voffB[i] = (unsigned)(Rb * K + C) * 2u; }
    const size_t kstep = (size_t)(BK * 2);
    const size_t hstep = (size_t)HALF * K * 2;
    const size_t tstep = 2 * hstep;
    const unsigned ldsw = (unsigned)wid * 1024u;
    const int aoff = lds_byte(wr * 64 + fr, fq * 8), boff = lds_byte(wc * 32 + fr, fq * 8);
#define PG8_SA(b, h) (((b) * 2 + (h)) * HTB)
#define PG8_SB(b, h) ((4 + (b) * 2 + (h)) * HTB)
#define PG8_STAGE(bufoff, gbase, voff) do { _Pragma("unroll") for (int _i = 0; _i < 2; ++_i) \
        __builtin_amdgcn_global_load_lds((const unsigned*)((const char*)(gbase) + (voff)[_i]), (LAS unsigned*)(lds + (bufoff) + ldsw + _i * 8192), 16, 0, 0); } while (0)
#define PG8_LDA(dst, b, h) do { _Pragma("unroll") for (int m = 0; m < 4; ++m) _Pragma("unroll") for (int k = 0; k < 2; ++k) dst[m][k] = *(const LAS bf16x8*)(lds + PG8_SA(b, h) + aoff + m * 2048 + k * 1024); } while (0)
#define PG8_LDB(dst, b, h) do { _Pragma("unroll") for (int n = 0; n < 2; ++n) _Pragma("unroll") for (int k = 0; k < 2; ++k) dst[n][k] = *(const LAS bf16x8*)(lds + PG8_SB(b, h) + boff + n * 2048 + k * 1024); } while (0)
#define PG8_MMA(ai, bj, At, Bt) do { __builtin_amdgcn_s_setprio(1); _Pragma("unroll") for (int m = 0; m < 4; ++m) _Pragma("unroll") for (int n = 0; n < 2; ++n) _Pragma("unroll") for (int k = 0; k < 2; ++k) \
        acc[ai][bj][m][n] = __builtin_amdgcn_mfma_f32_16x16x32_bf16(Bt[n][k], At[m][k], acc[ai][bj][m][n], 0, 0, 0); __builtin_amdgcn_s_setprio(0); } while (0)
#define PG8_WAIT_V(n) asm volatile("s_waitcnt vmcnt(" #n ")" ::: "memory")
#define PG8_WAIT_L(n) asm volatile("s_waitcnt lgkmcnt(" #n ")" ::: "memory")
#define PG8_BAR __builtin_amdgcn_s_barrier()
#define PG8_SCHED __builtin_amdgcn_sched_barrier(0)
    Unit cur, nxt; int ui = 0;
    if (!S.next(0, cur)) return;
    f32x4 acc[2][2][4][2];
#pragma unroll
    for (int a = 0; a < 2; ++a)
#pragma unroll
        for (int b = 0; b < 2; ++b)
#pragma unroll
            for (int m = 0; m < 4; ++m)
#pragma unroll
                for (int n = 0; n < 2; ++n) acc[a][b][m][n] = (f32x4){0.f, 0.f, 0.f, 0.f};
    bf16x8 At[4][2], B0[2][2], B1[2][2];
    const char* cA = (const char*)g.A + (size_t)cur.pm * tstep; const char* cB = (const char*)g.Bt + (size_t)cur.pn * tstep;
    PG8_STAGE(PG8_SB(0, 0), cB, voffB); PG8_STAGE(PG8_SA(0, 0), cA, voffA); PG8_STAGE(PG8_SB(0, 1), cB + hstep, voffB); PG8_STAGE(PG8_SA(0, 1), cA + hstep, voffA);
    if (wr == 1) PG8_BAR;
    PG8_WAIT_V(4); PG8_BAR;
    PG8_STAGE(PG8_SB(1, 0), cB + kstep, voffB); PG8_STAGE(PG8_SA(1, 0), cA + kstep, voffA); PG8_STAGE(PG8_SB(1, 1), cB + hstep + kstep, voffB);
    PG8_WAIT_V(6); PG8_BAR;
    for (;;) {
        const bool has_next = S.next(ui + 1, nxt);
        const char* nA = has_next ? (const char*)g.A + (size_t)nxt.pm * tstep : cA; const char* nB = has_next ? (const char*)g.Bt + (size_t)nxt.pn * tstep : cB;
        for (int t = 0; t < nt; t += 2) {
            const bool last = (t == nt - 2);
            const char* a1 = cA + (size_t)(t + 1) * kstep;
            const char* a2 = last ? nA : cA + (size_t)(t + 2) * kstep; const char* b2 = last ? nB : cB + (size_t)(t + 2) * kstep;
            const char* a3 = a2 + kstep; const char* b3 = b2 + kstep;
            PG8_LDB(B0, 0, 0); PG8_SCHED; PG8_LDA(At, 0, 0); PG8_STAGE(PG8_SA(1, 1), a1 + hstep, voffA);
            PG8_WAIT_L(8); PG8_BAR; PG8_WAIT_L(0); PG8_MMA(0, 0, At, B0); PG8_BAR; PG8_SCHED;
            PG8_LDB(B1, 0, 1); PG8_STAGE(PG8_SB(0, 0), b2, voffB);
            PG8_BAR; PG8_WAIT_L(0); PG8_MMA(0, 1, At, B1); PG8_BAR;
            PG8_LDA(At, 0, 1); PG8_STAGE(PG8_SA(0, 0), a2, voffA);
            PG8_BAR; PG8_WAIT_L(0); PG8_MMA(1, 0, At, B0); PG8_BAR; PG8_SCHED;
            PG8_STAGE(PG8_SB(0, 1), b2 + hstep, voffB);
            PG8_WAIT_V(6); PG8_BAR; PG8_MMA(1, 1, At, B1); PG8_BAR;
            PG8_LDB(B0, 1, 0); PG8_SCHED; PG8_LDA(At, 1, 0); PG8_STAGE(PG8_SA(0, 1), a2 + hstep, voffA);
            PG8_WAIT_L(8); PG8_BAR; PG8_WAIT_L(0); PG8_MMA(0, 0, At, B0); PG8_BAR; PG8_SCHED;
            PG8_LDB(B1, 1, 1); PG8_STAGE(PG8_SB(1, 0), b3, voffB);
            PG8_BAR; PG8_WAIT_L(0); PG8_MMA(0, 1, At, B1); PG8_BAR;
            PG8_LDA(At, 1, 1); PG8_STAGE(PG8_SA(1, 0), a3, voffA);
            PG8_BAR; PG8_WAIT_L(0); PG8_MMA(1, 0, At, B0); PG8_BAR; PG8_SCHED;
            PG8_STAGE(PG8_SB(1, 1), b3 + hstep, voffB);
            PG8_WAIT_V(6); PG8_BAR; PG8_MMA(1, 1, At, B1); PG8_BAR;
        }
        E(acc, cur, wr, wc, fr, fq);
        if (!has_next) break;
#pragma unroll
        for (int a = 0; a < 2; ++a)
#pragma unroll
            for (int b = 0; b < 2; ++b)
#pragma unroll
                for (int m = 0; m < 4; ++m)
#pragma unroll
                    for (int n = 0; n < 2; ++n) acc[a][b][m][n] = (f32x4){0.f, 0.f, 0.f, 0.f};
        cur = nxt; cA = nA; cB = nB; ++ui;
    }
    PG8_WAIT_V(0);
    if (wr == 0) PG8_BAR;
    PG8_BAR;
#undef PG8_SA
#undef PG8_SB
#undef PG8_STAGE
#undef PG8_LDA
#undef PG8_LDB
#undef PG8_MMA
#undef PG8_WAIT_V
#undef PG8_WAIT_L
#undef PG8_BAR
#undef PG8_SCHED
}
}
using pg8::Unit;

struct EpiIn0 {
    static constexpr bool PERM = true;
    bf16_t* T1; bf16_t* OG;
    DI void operator()(const f32x4 (&acc)[2][2][4][2], const Unit& u, int wr, int wc, int fr, int fq) const {
        const int row0 = u.pm * 256 + wr * 64 + fr;
        bf16_t* base; int ldc, colt, act;
        if (u.pn < 16) { base = T1; ldc = 4096; colt = u.pn * 256; act = 0; }
        else { base = OG; ldc = 2048; colt = (u.pn - 16) * 256; act = (u.pn < 20) ? 1 : 2; }
        const int col0 = colt + wc * 32 + 8 * fq;
#pragma unroll
        for (int ai = 0; ai < 2; ++ai)
#pragma unroll
            for (int m = 0; m < 4; ++m) {
                bf16_t* rowp = base + (size_t)(row0 + ai * 128 + m * 16) * ldc + col0;
#pragma unroll
                for (int bj = 0; bj < 2; ++bj) {
                    f32x4 v0 = acc[ai][bj][m][0], v1 = acc[ai][bj][m][1];
                    if (act == 1) {
#pragma unroll
                        for (int j = 0; j < 4; ++j) { v0[j] = sigmoidf_(v0[j]); v1[j] = sigmoidf_(v1[j]); }
                    } else if (act == 2) {
#pragma unroll
                        for (int j = 0; j < 4; ++j) { v0[j] = gelu_tanh(v0[j]); v1[j] = gelu_tanh(v1[j]); }
                    }
                    u32x4 w; w.x = pk2(v0[0], v0[1]); w.y = pk2(v0[2], v0[3]); w.z = pk2(v1[0], v1[1]); w.w = pk2(v1[2], v1[3]);
                    *(u32x4*)(rowp + bj * 128) = w;
                }
            }
    }
};

template <int MODE, bool WRITE_HB = true>
struct EpiRes {
    static constexpr bool PERM = false;
    float* h; bf16_t* hb; float* ss; const float* x; const float* meta;
    DI void operator()(const f32x4 (&acc)[2][2][4][2], const Unit& u, int wr, int wc, int fr, int fq) const {
        const int row0 = u.pm * 256 + wr * 64 + fr, col0 = u.pn * 256 + wc * 32 + 4 * fq;
#pragma unroll
        for (int ai = 0; ai < 2; ++ai)
#pragma unroll
            for (int m = 0; m < 4; ++m) {
                const int r = row0 + ai * 128 + m * 16;
                const float* rp;
                if (MODE == 0) rp = x + (size_t)r * 1024;
                else rp = h + (size_t)r * 1024;
                float sq = 0.f;
#pragma unroll
                for (int bj = 0; bj < 2; ++bj)
#pragma unroll
                    for (int n = 0; n < 2; ++n) {
                        const int c = col0 + bj * 128 + n * 16;
                        f32x4 rv = rp ? *(const f32x4*)(rp + c) : (f32x4){0.f, 0.f, 0.f, 0.f};
                        f32x4 v = acc[ai][bj][m][n] + rv;
                        *(f32x4*)(h + (size_t)r * 1024 + c) = v;
                        if (WRITE_HB) {
                            u32x2 w; w.x = pk2(v[0], v[1]); w.y = pk2(v[2], v[3]);
                            *(u32x2*)(hb + (size_t)r * 1024 + c) = w;
                        }
                        sq += v[0] * v[0] + v[1] * v[1] + v[2] * v[2] + v[3] * v[3];
                    }
                sq = sum_x16_x32(sq);
                if (fq == 0) atomicAdd(ss + r, sq);
            }
    }
};

struct EpiUp {
    static constexpr bool PERM = true;
    bf16_t* HID; const float* ss;
    DI void operator()(const f32x4 (&acc)[2][2][4][2], const Unit& u, int wr, int wc, int fr, int fq) const {
        const int row0 = u.pm * 256 + wr * 64 + fr, col0 = u.pn * 256 + wc * 32 + 8 * fq;
#pragma unroll
        for (int ai = 0; ai < 2; ++ai)
#pragma unroll
            for (int m = 0; m < 4; ++m) {
                const int r = row0 + ai * 128 + m * 16;
                const float rstd = rsqrtf(ss[r] * (1.0f / 1024.0f) + EPS);
                bf16_t* rowp = HID + (size_t)r * 4096 + col0;
#pragma unroll
                for (int bj = 0; bj < 2; ++bj) {
                    f32x4 v0 = acc[ai][bj][m][0] * rstd, v1 = acc[ai][bj][m][1] * rstd;
#pragma unroll
                    for (int j = 0; j < 4; ++j) { float a = fmaxf(v0[j], 0.f), b = fmaxf(v1[j], 0.f); v0[j] = a * a; v1[j] = b * b; }
                    u32x4 w; w.x = pk2(v0[0], v0[1]); w.y = pk2(v0[2], v0[3]); w.z = pk2(v1[0], v1[1]); w.w = pk2(v1[2], v1[3]);
                    *(u32x4*)(rowp + bj * 128) = w;
                }
            }
    }
};

struct EpiQK {
    static constexpr bool PERM = true;
    bf16_t* QK; const float* ss; const float* rope;
    DI void operator()(const f32x4 (&acc)[2][2][4][2], const Unit& u, int wr, int wc, int fr, int fq) const {
        const int row0 = u.pm * 256 + wr * 64 + fr, col0 = u.pn * 256 + wc * 32 + 8 * fq;
        const bool rot = (wc & 1) == 0;
#pragma unroll
        for (int ai = 0; ai < 2; ++ai)
#pragma unroll
            for (int m = 0; m < 4; ++m) {
                const int r = row0 + ai * 128 + m * 16;
                const float rstd = rsqrtf(ss[r] * (1.0f / 1024.0f) + EPS);
                const int t = r < MR ? 16 + (r & 4095) : ((r - MR) & 15);
                f32x4 cs[2], sn[2];
                if (rot) {
                    cs[0] = *(const f32x4*)(rope + t * 16); cs[1] = *(const f32x4*)(rope + t * 16 + 4);
                    sn[0] = *(const f32x4*)(rope + t * 16 + 8); sn[1] = *(const f32x4*)(rope + t * 16 + 12);
                }
                bf16_t* rowp = QK + (size_t)r * 2048 + col0;
#pragma unroll
                for (int bj = 0; bj < 2; ++bj) {
                    f32x4 v[2]; v[0] = acc[ai][bj][m][0] * rstd; v[1] = acc[ai][bj][m][1] * rstd;
                    if (rot) {
#pragma unroll
                        for (int n = 0; n < 2; ++n)
#pragma unroll
                            for (int j = 0; j < 4; ++j) {
                                const auto sw = __builtin_amdgcn_permlane16_swap(__float_as_uint(v[n][j]), __float_as_uint(v[n][j]), false, false);
                                const float other = __uint_as_float((fq & 1) ? sw[0] : sw[1]);
                                const float mine = v[n][j];
                                const float ra = mine * cs[n][j] - other * sn[n][j];
                                const float rb = mine * cs[n][j] + other * sn[n][j];
                                v[n][j] = fq == 0 ? ra : (fq == 1 ? rb : mine);
                            }
                    }
                    u32x4 w; w.x = pk2(v[0][0], v[0][1]); w.y = pk2(v[0][2], v[0][3]); w.z = pk2(v[1][0], v[1][1]); w.w = pk2(v[1][2], v[1][3]);
                    *(u32x4*)(rowp + bj * 128) = w;
                }
            }
    }
};

struct EpiVT {
    static constexpr bool PERM = true;
    bf16_t* VT; const float* ss;
    DI void operator()(const f32x4 (&acc)[2][2][4][2], const Unit& u, int wr, int wc, int fr, int fq) const {
        const int row0 = u.pm * 256 + wr * 64 + fr, col0 = u.pn * 256 + wc * 32 + 8 * fq;
        f32x4 rs[2][2];
#pragma unroll
        for (int bj = 0; bj < 2; ++bj)
#pragma unroll
            for (int n = 0; n < 2; ++n) {
                f32x4 s = *(const f32x4*)(ss + col0 + bj * 128 + 4 * n);
#pragma unroll
                for (int j = 0; j < 4; ++j) rs[bj][n][j] = rsqrtf(s[j] * (1.0f / 1024.0f) + EPS);
            }
#pragma unroll
        for (int ai = 0; ai < 2; ++ai)
#pragma unroll
            for (int m = 0; m < 4; ++m) {
                bf16_t* rowp = VT + (size_t)(row0 + ai * 128 + m * 16) * MP + col0;
#pragma unroll
                for (int bj = 0; bj < 2; ++bj) {
                    f32x4 v0 = acc[ai][bj][m][0] * rs[bj][0], v1 = acc[ai][bj][m][1] * rs[bj][1];
                    bf16_t* g16 = rowp + bj * 128 - 8 * (fq & 1);
                    u32x2 w0; w0.x = pk2(v0[0], v0[1]); w0.y = pk2(v0[2], v0[3]);
                    u32x2 w1; w1.x = pk2(v1[0], v1[1]); w1.y = pk2(v1[2], v1[3]);
                    *(u32x2*)(g16 + ((fq & 1) ? 4 : 0)) = w0;
                    *(u32x2*)(g16 + ((fq & 1) ? 12 : 8)) = w1;
                }
            }
    }
};

DI float wt_kscale(const Params& p, int job, int k) {
    switch (job) {
        case 0: return p.norm_mix[k];
        case 1: return k < 1024 ? p.mlstm_norm[k] : 1.0f;
        case 2: return p.norm_mlp[k];
        case 4: return p.norm_mix[1024 + k];
        case 5: return p.c_subln[k & 127] * (1.0f - LAMBDA_INIT);
        case 6: return p.norm_mlp[1024 + k];
        default: return 1.0f;
    }
}
DI void wt_colmap(int job, int n, int& scol, float& cs) {
    scol = n; cs = 1.0f;
    if (job == 0) {
        if (n < 3072) { cs = (n >= 1024 && n < 2048) ? 0.0625f : 1.0f; }
        else if (n < 4096) scol = n + 1032;
        else if (n < 5120) scol = n - 1024;
        else scol = n + 8;
    } else if (job == 4) {
        if (n < 1024) cs = 0.125f * LOG2E;
    }
}

DI void wt_convert(const Params& p, unsigned char* smem, int job_lo, int job_hi, int bid, int nblk) {
    const int tid = tid_fresh();
    float* tile = (float*)smem;
    for (int job = job_lo; job < job_hi; ++job) {
        const float* src; int ld, K, N; size_t off;
        switch (job) {
            case 0: src = p.ab_w_in; ld = 6152; K = 1024; N = 6144; off = OFF_WIN0; break;
            case 1: src = p.ab_w_out; ld = 1024; K = 2048; N = 1024; off = OFF_WOUT0; break;
            case 2: src = p.mlp_w1; ld = 4096; K = 1024; N = 4096; off = OFF_WM10; break;
            case 3: src = p.mlp_w2; ld = 1024; K = 4096; N = 1024; off = OFF_WM20; break;
            case 4: src = p.c_w_in; ld = 3072; K = 1024; N = 3072; off = OFF_WIN1; break;
            case 5: src = p.c_w_out; ld = 1024; K = 1024; N = 1024; off = OFF_WOUT1; break;
            case 6: src = p.mlp_w1 + 1024ull * 4096; ld = 4096; K = 1024; N = 4096; off = OFF_WM11; break;
            default: src = p.mlp_w2 + 4096ull * 1024; ld = 1024; K = 4096; N = 1024; off = OFF_WM21; break;
        }
        bf16_t* dst = (bf16_t*)(p.ws + off);
        const int tn = N / 256, tk = K / 64;
        for (int t = bid; t < tn * tk; t += nblk) {
            const int n0 = (t % tn) * 256, k0 = (t / tn) * 64;
            {
                const int tx = tid & 63, ty = tid >> 6;
                float ksc[8];
#pragma unroll
                for (int i = 0; i < 8; ++i) ksc[i] = wt_kscale(p, job, k0 + ty * 8 + i);
#pragma unroll
                for (int cg = 0; cg < 4; ++cg) {
                    int scol; float cs; wt_colmap(job, n0 + cg * 64 + tx, scol, cs);
#pragma unroll
                    for (int i = 0; i < 8; ++i) tile[(ty * 8 + i) * 257 + cg * 64 + tx] = src[(size_t)(k0 + ty * 8 + i) * ld + scol] * (cs * ksc[i]);
                }
            }
            __syncthreads();
#pragma unroll
            for (int q = 0; q < 4; ++q) {
                const int vid = tid + 512 * q, nl = vid >> 3, ks = vid & 7;
                float v[8];
#pragma unroll
                for (int j = 0; j < 8; ++j) v[j] = tile[(ks * 8 + j) * 257 + nl];
                u32x4 w; w.x = pk2(v[0], v[1]); w.y = pk2(v[2], v[3]); w.z = pk2(v[4], v[5]); w.w = pk2(v[6], v[7]);
                *(u32x4*)(dst + (size_t)(n0 + nl) * K + k0 + ks * 8) = w;
            }
            __syncthreads();
        }
    }
}

DI void prologue_phase(const Params& p, unsigned char* smem) {
    const int tid = tid_fresh(), lane = tid & 63, wid = tid >> 6;
    wt_convert(p, smem, 0, 1, blockIdx.x, gridDim.x);
    {
        bf16_t* dst = (bf16_t*)(p.ws + OFF_WLRU);
        for (int i = blockIdx.x * 512 + tid; i < 2 * 8 * 128 * 128; i += gridDim.x * 512) {
            const int d = i & 127, e = (i >> 7) & 127, which = (i >> 14) & 1, n = i >> 15;
            const float* w = which ? p.w_i : p.w_r;
            dst[i] = f2bf(w[(n * 128 + d) * 128 + e]);
        }
    }
    if (blockIdx.x == 0 && wid == 0) {
        const float a = wave_sum(p.c_lambda[lane] * p.c_lambda[64 + lane]);
        const float c = wave_sum(p.c_lambda[128 + lane] * p.c_lambda[192 + lane]);
        if (lane == 0) ((float*)(p.ws + OFF_MISC))[0] = expf(a) - expf(c) + LAMBDA_INIT;
    }
    {
        float* z = (float*)(p.ws + OFF_SS);
        for (int i = blockIdx.x * 512 + tid; i < 8 * MP; i += gridDim.x * 512) z[i] = 0.f;
        float* rope = (float*)(p.ws + OFF_ROPE);
        for (int i = blockIdx.x * 512 + tid; i < TSEQ * 8; i += gridDim.x * 512) {
            const int t = i >> 3, j = i & 7;
            const float invf[8] = {1.0f, 0.1939227432012558f, 0.03760603070259094f, 0.007292664609849453f, 0.0014142135623842478f,
                                   0.00027424818836152554f, 5.3182957344688475e-05f, 1.0313385246263351e-05f};
            float f = 1.0f;
#pragma unroll
            for (int q = 0; q < 8; ++q) f = (j == q) ? invf[q] : f;
            const float ang = (float)t * f;
            const float kk = rintf(ang * 0.15915494309189535f);
            float r = fmaf(-kk, 6.28125f, ang);
            r = fmaf(-kk, 1.9353071795864769e-3f, r);
            rope[t * 16 + j] = __cosf(r);
            rope[t * 16 + 8 + j] = __sinf(r);
        }
    }
    {
        float* wg = (float*)smem;
        __syncthreads();
        for (int i = tid; i < 8192; i += 512) { const int k = i >> 3, j = i & 7; wg[i] = p.ab_w_in[(size_t)k * 6152 + 4096 + j] * p.norm_mix[k]; }
        __syncthreads();
        bf16_t* hn = (bf16_t*)(p.ws + OFF_HB);
        float* LI = (float*)(p.ws + OFF_LI); float* LF = (float*)(p.ws + OFF_LF);
        const int rstep = gridDim.x * 8;
        int r = blockIdx.x * 8 + wid;
        f32x4 nx[4];
        auto load_row = [&](int rr) __attribute__((always_inline)) {
            const float* s = rr < MR ? p.x + (size_t)rr * 1024 : p.meta + (size_t)(rr - MR) * 1024;
#pragma unroll
            for (int i = 0; i < 4; ++i) nx[i] = *(const f32x4*)(s + i * 256 + lane * 4);
        };
        if (r < MR + 16) load_row(r);
        for (; r < MR + 16; r += rstep) {
            f32x4 v[4];
#pragma unroll
            for (int i = 0; i < 4; ++i) v[i] = nx[i];
            if (r + rstep < MR + 16) load_row(r + rstep);
            float sq = 0.f;
#pragma unroll
            for (int i = 0; i < 4; ++i) sq += v[i][0] * v[i][0] + v[i][1] * v[i][1] + v[i][2] * v[i][2] + v[i][3] * v[i][3];
            float g[8];
#pragma unroll
            for (int j = 0; j < 8; ++j) g[j] = 0.f;
#pragma unroll
            for (int i = 0; i < 4; ++i) {
#pragma unroll
                for (int e = 0; e < 4; ++e) {
                    const float* wr_ = wg + (i * 256 + lane * 4 + e) * 8;
                    const f32x4 w0 = *(const f32x4*)wr_, w1 = *(const f32x4*)(wr_ + 4);
                    g[0] += v[i][e] * w0[0]; g[1] += v[i][e] * w0[1]; g[2] += v[i][e] * w0[2]; g[3] += v[i][e] * w0[3];
                    g[4] += v[i][e] * w1[0]; g[5] += v[i][e] * w1[1]; g[6] += v[i][e] * w1[2]; g[7] += v[i][e] * w1[3];
                }
            }
            sq = wave_sum(sq);
            const float rstd = rsqrtf(sq * (1.0f / 1024.0f) + EPS);
#pragma unroll
            for (int i = 0; i < 4; ++i) {
                u32x2 w; w.x = pk2(v[i][0] * rstd, v[i][1] * rstd); w.y = pk2(v[i][2] * rstd, v[i][3] * rstd);
                *(u32x2*)(hn + (size_t)r * 1024 + i * 256 + lane * 4) = w;
            }
            float h4[4], h2[2], h1;
            {
                const bool up = (lane & 32) != 0;
#pragma unroll
                for (int j = 0; j < 4; ++j) { const float mine = up ? g[4 + j] : g[j], send = up ? g[j] : g[4 + j]; h4[j] = mine + __shfl_xor(send, 32); }
            }
            {
                const bool up = (lane & 16) != 0;
#pragma unroll
                for (int j = 0; j < 2; ++j) { const float mine = up ? h4[2 + j] : h4[j], send = up ? h4[j] : h4[2 + j]; h2[j] = mine + __shfl_xor(send, 16); }
            }
            {
                const bool up = (lane & 8) != 0;
                const float mine = up ? h2[1] : h2[0], send = up ? h2[0] : h2[1];
                h1 = mine + __shfl_xor(send, 8);
            }
            h1 += __shfl_xor(h1, 4); h1 += __shfl_xor(h1, 2); h1 += __shfl_xor(h1, 1);
            if ((lane & 7) == 0) {
                const int gi = ((lane >> 5) & 1) * 4 + ((lane >> 4) & 1) * 2 + ((lane >> 3) & 1);
                const float pre = h1 * rstd + p.ab_if_bias[gi];
                if (gi < 4) LI[r * 4 + gi] = pre;
                else LF[r * 4 + gi - 4] = fminf(pre, 0.f) - log1pf(__expf(-fabsf(pre)));
            }
        }
    }
}

DI f32x4 mfma16(bf16x8 a, bf16x8 b, f32x4 c) { return __builtin_amdgcn_mfma_f32_16x16x32_bf16(a, b, c, 0, 0, 0); }
DI f32x16 mfma32(bf16x8 a, bf16x8 b, f32x16 c) { return __builtin_amdgcn_mfma_f32_32x32x16_bf16(a, b, c, 0, 0, 0); }

DI void mlstm_unit(const Params& p, unsigned char* smem, int unit) {
    const int tid = tid_fresh(), lane = tid & 63, wid = tid >> 6, fr = lane & 15, fq = lane >> 4;
    const int b = unit >> 4, h = (unit >> 2) & 3, sl = unit & 3;
    bf16_t* sQ = (bf16_t*)smem;
    bf16_t* sK = sQ + 64 * 264;
    bf16_t* sCb = sK + 64 * 264;
    bf16_t* sKwt = sCb + 64 * 264;
    bf16_t* sVt = sKwt + 256 * 72;
    bf16_t* sSd = sVt + 64 * 72;
    float* sN = (float*)(sSd + 64 * 72);
    float* gbuf = sN + 256;
    float* snq = gbuf + 2 * 336; float* srs = snq + 64;
    const bf16_t* T1 = (const bf16_t*)(p.ws + OFF_R2);
    bf16_t* OG = (bf16_t*)(p.ws + OFF_R3);
    const float* LI = (const float*)(p.ws + OFF_LI); const float* LF = (const float*)(p.ws + OFF_LF);
    float* HSS = (float*)(p.ws + OFF_HSS);

    f32x4 accC[2][4];
#pragma unroll
    for (int a = 0; a < 2; ++a)
#pragma unroll
        for (int v = 0; v < 4; ++v) accC[a][v] = (f32x4){0.f, 0.f, 0.f, 0.f};
    if (tid < 256) sN[tid] = 0.f;
    float m_prev = 0.f;
    const int ti = wid >> 1, pi = (wid & 1) * 2;

    u32x4 rq[4], rk[4], rv; float rli = 0.f, rlf = 0.f; u32x2 rog[2];
    auto issue_loads = [&](int c) __attribute__((always_inline)) {
        const int base = c == 0 ? MR : b * 4096 + (c - 1) * 64;
        const int nv = c == 0 ? 16 : 64;
#pragma unroll
        for (int i = 0; i < 4; ++i) {
            const int vid = tid + 512 * i, s = vid >> 5, kv = vid & 31;
            const size_t row = (size_t)(base + (s < nv ? s : nv - 1));
            rq[i] = *(const u32x4*)(T1 + row * 4096 + h * 256 + kv * 8);
            rk[i] = *(const u32x4*)(T1 + row * 4096 + 1024 + h * 256 + kv * 8);
        }
        {
            const int s = lane, vv = wid;
            const size_t row = (size_t)(base + (s < nv ? s : nv - 1));
            rv = *(const u32x4*)(T1 + row * 4096 + 2048 + h * 256 + sl * 64 + vv * 8);
        }
        if (wid == 0) {
            const bool ok = lane < nv;
            const int row = base + (ok ? lane : 0);
            rli = ok ? LI[row * 4 + h] : -1e30f;
            rlf = ok ? LF[row * 4 + h] : 0.f;
        }
        {
            const int t = ti * 16 + fr;
            const size_t row = (size_t)(base + (t < nv ? t : 0));
#pragma unroll
            for (int x = 0; x < 2; ++x) rog[x] = *(const u32x2*)(OG + row * 2048 + h * 256 + sl * 64 + (pi + x) * 16 + fq * 4);
        }
    };
    auto gate_scan = [&](float* gb) __attribute__((always_inline)) {
        const float bb = wave_scan_add(rlf);
        const float g = rli - bb;
        const float cm = wave_scan_max(g);
        const float Mt = fmaxf(m_prev, cm);
        const float M63 = __builtin_bit_cast(float, __builtin_amdgcn_readlane(__builtin_bit_cast(int, Mt), 63));
        const float b63 = __builtin_bit_cast(float, __builtin_amdgcn_readlane(__builtin_bit_cast(int, bb), 63));
        gb[lane] = g; gb[64 + lane] = Mt; gb[128 + lane] = __expf(m_prev - Mt); gb[192 + lane] = __expf(-(bb + Mt)); gb[256 + lane] = __expf(g - M63);
        if (lane == 0) gb[320] = __expf(m_prev - M63);
        m_prev = b63 + M63;
    };
    issue_loads(0);
    if (wid == 0) gate_scan(gbuf);
    __syncthreads();

    for (int c = 0; c < 65; ++c) {
        const int base = c == 0 ? MR : b * 4096 + (c - 1) * 64;
        const int nv = c == 0 ? 16 : 64;
        const bool wr_out = c > 0 || b == 0;
        const float* sg = gbuf + (c & 1) * 336; const float* sMt = sg + 64; const float* swp = sg + 128; const float* semt = sg + 192; const float* sws = sg + 256; const float* sdec = sg + 320;
#pragma unroll
        for (int a = 0; a < 2; ++a)
#pragma unroll
            for (int v = 0; v < 4; ++v) {
                u32x2 w; w.x = pk2(accC[a][v][0], accC[a][v][1]); w.y = pk2(accC[a][v][2], accC[a][v][3]);
                *(u32x2*)(sCb + (v * 16 + fr) * 264 + (2 * wid + a) * 16 + fq * 4) = w;
            }
#pragma unroll
        for (int i = 0; i < 4; ++i) {
            const int vid = tid + 512 * i, s = vid >> 5, kv = vid & 31;
            *(u32x4*)(sQ + s * 264 + kv * 8) = rq[i];
            *(u32x4*)(sK + s * 264 + kv * 8) = rk[i];
        }
        {
            const int s = lane, vv = wid;
            const unsigned wv[4] = {rv.x, rv.y, rv.z, rv.w};
#pragma unroll
            for (int e = 0; e < 4; ++e) {
                sVt[(vv * 8 + 2 * e) * 72 + s] = (bf16_t)(wv[e] & 0xffffu);
                sVt[(vv * 8 + 2 * e + 1) * 72 + s] = (bf16_t)(wv[e] >> 16);
            }
        }
        __syncthreads();
        const u32x2 og0 = rog[0], og1 = rog[1];
        if (c + 1 < 65) issue_loads(c + 1);
        {
            bf16_t raw[4][8]; f32x4 wa[4], wb[4];
#pragma unroll
            for (int i = 0; i < 4; ++i) {
                const int task = tid + 512 * i, k = task & 255, s0 = (task >> 8) * 8;
                wa[i] = *(const f32x4*)(sws + s0); wb[i] = *(const f32x4*)(sws + s0 + 4);
#pragma unroll
                for (int e = 0; e < 8; ++e) raw[i][e] = sK[(s0 + e) * 264 + k];
            }
            asm volatile("s_waitcnt lgkmcnt(0)" ::: "memory");
#pragma unroll
            for (int i = 0; i < 4; ++i) {
                const int task = tid + 512 * i, k = task & 255, s0 = (task >> 8) * 8;
                float v[8];
#pragma unroll
                for (int e = 0; e < 4; ++e) { v[e] = bf2f(raw[i][e]) * wa[i][e]; v[4 + e] = bf2f(raw[i][4 + e]) * wb[i][e]; }
                u32x4 w; w.x = pk2(v[0], v[1]); w.y = pk2(v[2], v[3]); w.z = pk2(v[4], v[5]); w.w = pk2(v[6], v[7]);
                *(u32x4*)(sKwt + k * 72 + s0) = w;
            }
        }
        f32x4 accH[2];
        {
            bf16x8 Bq[8];
#pragma unroll
            for (int ks = 0; ks < 8; ++ks) Bq[ks] = *(const bf16x8*)(sQ + (ti * 16 + fr) * 264 + ks * 32 + fq * 8);
            const int t = ti * 16 + fr;
            const float Mt_t = sMt[t];
#pragma unroll
            for (int x = 0; x < 2; ++x) {
                const int si = pi + x;
                if (si > ti) {
                    if (fq == 0) srs[si * 64 + t] = 0.f;
                    *(u32x2*)(sSd + t * 72 + si * 16 + fq * 4) = (u32x2){0u, 0u};
                    continue;
                }
                f32x4 aS = (f32x4){0.f, 0.f, 0.f, 0.f};
#pragma unroll
                for (int ks = 0; ks < 8; ++ks) aS = mfma16(*(const bf16x8*)(sK + (si * 16 + fr) * 264 + ks * 32 + fq * 8), Bq[ks], aS);
                float val[4]; float ps = 0.f;
                const f32x4 gv = *(const f32x4*)(sg + si * 16 + fq * 4);
#pragma unroll
                for (int j = 0; j < 4; ++j) {
                    const int s = si * 16 + fq * 4 + j;
                    const float e = __expf(fminf(gv[j] - Mt_t, 0.f));
                    const float d = (s <= t) ? e : 0.f;
                    val[j] = aS[j] * d; ps += val[j];
                }
                ps = sum_x16_x32(ps);
                if (fq == 0) srs[si * 64 + t] = ps;
                u32x2 w; w.x = pk2(val[0], val[1]); w.y = pk2(val[2], val[3]);
                *(u32x2*)(sSd + t * 72 + si * 16 + fq * 4) = w;
            }
#pragma unroll
            for (int x = 0; x < 2; ++x) {
                const int vi = pi + x;
                f32x4 aH = (f32x4){0.f, 0.f, 0.f, 0.f};
#pragma unroll
                for (int ks = 0; ks < 8; ++ks) aH = mfma16(*(const bf16x8*)(sCb + (vi * 16 + fr) * 264 + ks * 32 + fq * 8), Bq[ks], aH);
                accH[x] = aH;
            }
        }
        {
            const int t = tid >> 3, part = tid & 7;
            float s = 0.f;
#pragma unroll
            for (int i = 0; i < 4; ++i) {
                const u32x4 qv = *(const u32x4*)(sQ + t * 264 + part * 32 + i * 8);
                const f32x4 na = *(const f32x4*)(sN + part * 32 + i * 8), nb = *(const f32x4*)(sN + part * 32 + i * 8 + 4);
                s += bflo(qv.x) * na[0] + bfhi(qv.x) * na[1] + bflo(qv.y) * na[2] + bfhi(qv.y) * na[3]
                   + bflo(qv.z) * nb[0] + bfhi(qv.z) * nb[1] + bflo(qv.w) * nb[2] + bfhi(qv.w) * nb[3];
            }
            s += __shfl_xor(s, 1); s += __shfl_xor(s, 2); s += __shfl_xor(s, 4);
            if (part == 0) snq[t] = s;
        }
        __syncthreads();
        {
            const int t = ti * 16 + fr;
            const float wp = swp[t];
            const float den = wp * snq[t] + (srs[t] + srs[64 + t]) + (srs[128 + t] + srs[192 + t]);
            const float inv = __builtin_amdgcn_rcpf(fmaxf(fabsf(den), semt[t]));
            const bool ok = t < nv && wr_out;
            const size_t row = (size_t)(base + (ok ? t : 0));
            float sq = 0.f;
#pragma unroll
            for (int x = 0; x < 2; ++x) {
                const int vi = pi + x;
                f32x4 a = accH[x] * wp;
#pragma unroll
                for (int k2 = 0; k2 < 2; ++k2)
                    a = mfma16(*(const bf16x8*)(sVt + (vi * 16 + fr) * 72 + k2 * 32 + fq * 8), *(const bf16x8*)(sSd + t * 72 + k2 * 32 + fq * 8), a);
                bf16_t* op = OG + row * 2048 + h * 256 + sl * 64 + vi * 16 + fq * 4;
                if (ok) {
                    const u32x2 ov = x == 0 ? og0 : og1;
                    const float h0 = a[0] * inv * bflo(ov.x), h1 = a[1] * inv * bfhi(ov.x), h2 = a[2] * inv * bflo(ov.y), h3 = a[3] * inv * bfhi(ov.y);
                    u32x2 w; w.x = pk2(h0, h1); w.y = pk2(h2, h3);
                    *(u32x2*)op = w;
                    sq += h0 * h0 + h1 * h1 + h2 * h2 + h3 * h3;
                }
            }
            sq = sum_x16_x32(sq);
            if (fq == 0 && ok) atomicAdd(HSS + row * 4 + h, sq);
        }
        {
            const float dec = sdec[0];
            bf16x8 Bv[4][2];
#pragma unroll
            for (int v = 0; v < 4; ++v)
#pragma unroll
                for (int k2 = 0; k2 < 2; ++k2) Bv[v][k2] = *(const bf16x8*)(sVt + (v * 16 + fr) * 72 + k2 * 32 + fq * 8);
#pragma unroll
            for (int a = 0; a < 2; ++a) {
                bf16x8 Ak[2];
#pragma unroll
                for (int k2 = 0; k2 < 2; ++k2) Ak[k2] = *(const bf16x8*)(sKwt + ((2 * wid + a) * 16 + fr) * 72 + k2 * 32 + fq * 8);
#pragma unroll
                for (int v = 0; v < 4; ++v) {
                    f32x4 acc = accC[a][v] * dec;
                    acc = mfma16(Ak[0], Bv[v][0], acc);
                    acc = mfma16(Ak[1], Bv[v][1], acc);
                    accC[a][v] = acc;
                }
            }
            if (tid < 256) {
                float s = 0.f;
#pragma unroll
                for (int i = 0; i < 8; ++i) {
                    const u32x4 kv = *(const u32x4*)(sKwt + tid * 72 + i * 8);
                    s += (bflo(kv.x) + bfhi(kv.x)) + (bflo(kv.y) + bfhi(kv.y)) + (bflo(kv.z) + bfhi(kv.z)) + (bflo(kv.w) + bfhi(kv.w));
                }
                sN[tid] = dec * sN[tid] + s;
            }
        }
        if (wid == 0 && c + 1 < 65) gate_scan(gbuf + ((c + 1) & 1) * 336);
        __syncthreads();
    }
}

DI void lru_unit(const Params& p, unsigned char* smem, int unit) {
    const int tid = tid_fresh(), lane = tid & 63, wid = tid >> 6, fr = lane & 15, fq = lane >> 4;
    const int b = unit >> 4, n = (unit >> 1) & 7, half = unit & 1;
    bf16_t* sW = (bf16_t*)smem;
    bf16_t* sRaw = sW + 128 * 136;
    bf16_t* sXc = sRaw + 68 * 128;
    float* sXf = (float*)(sXc + 64 * 136);
    float* sA = sXf + 64 * 64;
    float* sU = sA + 64 * 65;
    const bf16_t* T1 = (const bf16_t*)(p.ws + OFF_R2);
    bf16_t* OG = (bf16_t*)(p.ws + OFF_R3);
    const bf16_t* WL = (const bf16_t*)(p.ws + OFF_WLRU);
#pragma unroll
    for (int i = 0; i < 4; ++i) {
        const int vid = tid + 512 * i, rr = vid >> 4, part = vid & 15;
        const int which = rr >> 6, e = half * 64 + (rr & 63);
        *(u32x4*)(sW + rr * 136 + part * 8) = *(const u32x4*)(WL + ((size_t)((n * 2 + which) * 128 + e)) * 128 + part * 8);
    }
    const int d8 = tid & 15, tq = tid >> 4;
    float cw[4][8], cb[8];
#pragma unroll
    for (int e = 0; e < 8; ++e) {
        const int ch = n * 128 + d8 * 8 + e;
        cb[e] = p.conv_b[ch];
#pragma unroll
        for (int j = 0; j < 4; ++j) cw[j][e] = p.conv_w[j * 1024 + ch];
    }
    const int et = wid & 3;
    float br[4], bi[4], sp[4];
#pragma unroll
    for (int j = 0; j < 4; ++j) {
        const int ch = n * 128 + half * 64 + et * 16 + fq * 4 + j;
        br[j] = p.b_r[ch]; bi[j] = p.b_i[ch];
        const float l = p.lam[ch];
        sp[j] = fmaxf(-l, 0.f) + log1pf(__expf(-fabsf(l)));
    }
    float hstate = 0.f;

    u32x4 rr_[3], rg_;
    auto issue_loads = [&](int c) __attribute__((always_inline)) {
        const int t0 = c == 0 ? 0 : 16 + (c - 1) * 64;
        {
            const int t = tid >> 3, nvc = c == 0 ? 16 : 64;
            const size_t row = (size_t)((c == 0 ? MR : b * 4096 + (c - 1) * 64) + (t < nvc ? t : 0));
            rg_ = *(const u32x4*)(OG + row * 2048 + 1024 + n * 128 + half * 64 + (tid & 7) * 8);
        }
#pragma unroll
        for (int i = 0; i < 3; ++i) {
            const int vid = tid + 512 * i, ri = vid >> 4, part = vid & 15;
            const int tt = t0 - 3 + ri;
            u32x4 v = (u32x4){0u, 0u, 0u, 0u};
            if (ri < 67 && tt >= 0 && tt < TSEQ) {
                const size_t row = tt < 16 ? (size_t)(MR + tt) : (size_t)(b * 4096 + tt - 16);
                v = *(const u32x4*)(T1 + row * 4096 + 3072 + n * 128 + part * 8);
            }
            rr_[i] = v;
        }
    };
    issue_loads(0);
    __syncthreads();
    for (int c = 0; c < 65; ++c) {
        const int base = c == 0 ? MR : b * 4096 + (c - 1) * 64;
        const int nv = c == 0 ? 16 : 64;
#pragma unroll
        for (int i = 0; i < 3; ++i) {
            const int vid = tid + 512 * i, ri = vid >> 4, part = vid & 15;
            if (ri < 67) *(u32x4*)(sRaw + ri * 128 + part * 8) = rr_[i];
        }
        __syncthreads();
        const u32x4 gv = rg_;
        if (c + 1 < 65) issue_loads(c + 1);
        {
            float x[5][8];
#pragma unroll
            for (int r = 0; r < 5; ++r) {
                const u32x4 v = *(const u32x4*)(sRaw + (2 * tq + r) * 128 + d8 * 8);
                x[r][0] = bflo(v.x); x[r][1] = bfhi(v.x); x[r][2] = bflo(v.y); x[r][3] = bfhi(v.y);
                x[r][4] = bflo(v.z); x[r][5] = bfhi(v.z); x[r][6] = bflo(v.w); x[r][7] = bfhi(v.w);
            }
#pragma unroll
            for (int tt = 0; tt < 2; ++tt) {
                const int t = 2 * tq + tt;
                float o[8];
#pragma unroll
                for (int e = 0; e < 8; ++e) o[e] = cb[e] + cw[0][e] * x[tt][e] + cw[1][e] * x[tt + 1][e] + cw[2][e] * x[tt + 2][e] + cw[3][e] * x[tt + 3][e];
                u32x4 w; w.x = pk2(o[0], o[1]); w.y = pk2(o[2], o[3]); w.z = pk2(o[4], o[5]); w.w = pk2(o[6], o[7]);
                *(u32x4*)(sXc + t * 136 + d8 * 8) = w;
                if ((d8 >> 3) == half) {
                    float* xf = sXf + t * 64 + (d8 & 7) * 8;
                    *(f32x4*)xf = (f32x4){o[0], o[1], o[2], o[3]};
                    *(f32x4*)(xf + 4) = (f32x4){o[4], o[5], o[6], o[7]};
                }
            }
        }
        __syncthreads();
        {
            bf16x8 Ar[4], Ai[4];
#pragma unroll
            for (int ks = 0; ks < 4; ++ks) {
                Ar[ks] = *(const bf16x8*)(sW + (et * 16 + fr) * 136 + ks * 32 + fq * 8);
                Ai[ks] = *(const bf16x8*)(sW + (64 + et * 16 + fr) * 136 + ks * 32 + fq * 8);
            }
#pragma unroll
            for (int x = 0; x < 2; ++x) {
                const int t = ((wid >> 2) * 2 + x) * 16 + fr;
                f32x4 aR = (f32x4){0.f, 0.f, 0.f, 0.f}, aI = (f32x4){0.f, 0.f, 0.f, 0.f};
#pragma unroll
                for (int ks = 0; ks < 4; ++ks) {
                    const bf16x8 Bx = *(const bf16x8*)(sXc + t * 136 + ks * 32 + fq * 8);
                    aR = mfma16(Ar[ks], Bx, aR);
                    aI = mfma16(Ai[ks], Bx, aI);
                }
                const f32x4 xv = *(const f32x4*)(sXf + t * 64 + et * 16 + fq * 4);
#pragma unroll
                for (int j = 0; j < 4; ++j) {
                    const float r = sigmoidf_(aR[j] + br[j]), ig = sigmoidf_(aI[j] + bi[j]);
                    const float la = -8.0f * r * sp[j];
                    const float a = __expf(la);
                    const float u = sqrtf(fmaxf(-expm1f(2.0f * la), 0.f)) * (ig * xv[j]);
                    sA[t * 65 + et * 16 + fq * 4 + j] = a;
                    sU[t * 65 + et * 16 + fq * 4 + j] = u;
                }
            }
        }
        __syncthreads();
        if (wid == 0) {
            float hs = hstate;
            for (int t0 = 0; t0 < nv; t0 += 16) {
                float av[16], uv[16];
#pragma unroll
                for (int i = 0; i < 16; ++i) { av[i] = sA[(t0 + i) * 65 + lane]; uv[i] = sU[(t0 + i) * 65 + lane]; }
#pragma unroll
                for (int i = 0; i < 16; ++i) { hs = av[i] * hs + uv[i]; uv[i] = hs; }
#pragma unroll
                for (int i = 0; i < 16; ++i) sU[(t0 + i) * 65 + lane] = uv[i];
            }
            hstate = hs;
        }
        __syncthreads();
        {
            const int t = tid >> 3, e0 = (tid & 7) * 8;
            if (t < nv && (c > 0 || b == 0)) {
                bf16_t* op = OG + (size_t)(base + t) * 2048 + 1024 + n * 128 + half * 64 + e0;
                const float* hp = sU + t * 65 + e0;
                u32x4 w;
                w.x = pk2(hp[0] * bflo(gv.x), hp[1] * bfhi(gv.x)); w.y = pk2(hp[2] * bflo(gv.y), hp[3] * bfhi(gv.y));
                w.z = pk2(hp[4] * bflo(gv.z), hp[5] * bfhi(gv.z)); w.w = pk2(hp[6] * bflo(gv.w), hp[7] * bfhi(gv.w));
                *(u32x4*)op = w;
            }
        }
    }
    __syncthreads();
}

DI void mixer0_phase(const Params& p, unsigned char* smem, int mask = 3, bool conv = true) {
    for (int w = blockIdx.x; w < 256; w += gridDim.x) {
        if (w < 128) { if (mask & 1) mlstm_unit(p, smem, w); } else { if (mask & 2) lru_unit(p, smem, w - 128); }
        __syncthreads();
    }
    const int half = gridDim.x >> 1;
    if (conv && (int)blockIdx.x >= half) wt_convert(p, smem, 1, 8, blockIdx.x - half, gridDim.x - half);
}

DI void headnorm_phase(const Params& p) {
    const int tid = tid_fresh(), lane = tid & 63, wid = tid >> 6;
    bf16_t* OG = (bf16_t*)(p.ws + OFF_R3);
    const float* HSS = (const float*)(p.ws + OFF_HSS);
    for (int r = blockIdx.x * 8 + wid; r < MR + 16; r += gridDim.x * 8) {
        const float sc = rsqrtf(HSS[r * 4 + (lane >> 4)] * (1.0f / 256.0f) + EPS);
        bf16_t* op = OG + (size_t)r * 2048 + lane * 16;
#pragma unroll
        for (int i = 0; i < 2; ++i) {
            const u32x4 v = *(const u32x4*)(op + i * 8);
            u32x4 w;
            w.x = pk2(bflo(v.x) * sc, bfhi(v.x) * sc); w.y = pk2(bflo(v.y) * sc, bfhi(v.y) * sc);
            w.z = pk2(bflo(v.z) * sc, bfhi(v.z) * sc); w.w = pk2(bflo(v.w) * sc, bfhi(v.w) * sc);
            *(u32x4*)(op + i * 8) = w;
        }
    }
}

DI bf16x8 pack8(const f32x16& x, int s) {
    u32x4 w; w.x = pk2(x[8 * s], x[8 * s + 1]); w.y = pk2(x[8 * s + 2], x[8 * s + 3]); w.z = pk2(x[8 * s + 4], x[8 * s + 5]); w.w = pk2(x[8 * s + 6], x[8 * s + 7]);
    return __builtin_bit_cast(bf16x8, w);
}
DI void attn_phase(const Params& p, unsigned char* smem) {
    const int tid = tid_fresh(), lane = tid & 63, wid = tid >> 6, l31 = lane & 31, hi = lane >> 5;
    const int comp = wid & 1, qg = wid >> 1;
    LAS unsigned char* lds = (LAS unsigned char*)smem;
    bf16_t* sK = (bf16_t*)smem;
    bf16_t* sV = sK + 2 * 64 * 128;
    float* sO = (float*)smem;
    const bf16_t* QK = (const bf16_t*)(p.ws + OFF_QK1);
    const bf16_t* VT = (const bf16_t*)(p.ws + OFF_VT);
    bf16_t* AO = (bf16_t*)(p.ws + OFF_AO);
    const float lam = __builtin_bit_cast(float, __builtin_amdgcn_readfirstlane(((const int*)(p.ws + OFF_MISC))[0]));
    const int wu = __builtin_amdgcn_readfirstlane(wid);
    for (int unit = blockIdx.x; unit < 2048; unit += gridDim.x) {
        const int round = unit >> 8, i256 = unit & 255, bh = i256 >> 2, jj = i256 & 3;
        const int qb = (round & 1) ? 24 - 8 * (round >> 1) + jj : 31 - 8 * (round >> 1) - jj;
        const int b = bh >> 3, head = bh & 7;
        const int q0 = qb * 128 + qg * 32;
        bf16x8 Qf[4];
#pragma unroll
        for (int ks = 0; ks < 4; ++ks) Qf[ks] = *(const bf16x8*)(QK + (size_t)(b * 4096 + q0 + l31) * 2048 + head * 128 + comp * 64 + ks * 16 + hi * 8);
        f32x16 O[4];
#pragma unroll
        for (int d = 0; d < 4; ++d)
#pragma unroll
            for (int i = 0; i < 16; ++i) O[d][i] = 0.f;
        float mrun = -INFINITY, lrun = 0.f;
        const int ntile = 2 * (qb + 1) + 1;

        auto dma_tile = [&](int j, int buf) __attribute__((always_inline)) {
            const size_t krow0 = j == 0 ? (size_t)MR : (size_t)(b * 4096 + (j - 1) * 64);
#pragma unroll
            for (int i = 0; i < 2; ++i) {
                const int bi = wu * 2 + i;
                {
                    const int key = 4 * bi + (lane >> 4), part = (lane & 15) ^ (key & 15);
                    __builtin_amdgcn_global_load_lds((const unsigned*)(QK + (krow0 + key) * 2048 + 1024 + head * 128 + part * 8),
                                                     (LAS unsigned*)(lds + buf * 16384 + bi * 1024), 16, 0, 0);
                }
                {
                    const int dv = 8 * bi + (lane >> 3), ch = (lane & 7) ^ ((dv >> 1) & 7);
                    __builtin_amdgcn_global_load_lds((const unsigned*)(VT + (size_t)(head * 128 + dv) * MP + krow0 + ch * 8),
                                                     (LAS unsigned*)(lds + 32768 + buf * 16384 + bi * 1024), 16, 0, 0);
                }
            }
        };
        auto qk_half = [&](const bf16_t* kb, int kh, int ksw) __attribute__((always_inline)) {
            f32x16 S;
#pragma unroll
            for (int i = 0; i < 16; ++i) S[i] = 0.f;
#pragma unroll
            for (int ks = 0; ks < 4; ++ks)
                S = mfma32(*(const bf16x8*)(kb + (kh * 32 + l31) * 128 + (((comp * 8 + ks * 2 + hi) ^ ksw) * 8)), Qf[ks], S);
            return S;
        };
        auto softmax_half = [&](f32x16& S, int j, int kh, int kbase, bool need_mask, bf16x8 (&P)[2]) __attribute__((always_inline)) {
            if (need_mask) {
#pragma unroll
                for (int i = 0; i < 16; ++i) {
                    const int key = kh * 32 + 8 * (i >> 2) + 4 * hi + (i & 3);
                    const bool vis = (j == 0) ? (key < 16) : (kbase + key <= q0 + l31);
                    if (!vis) S[i] = -INFINITY;
                }
            }
            float mx = S[0];
#pragma unroll
            for (int i = 1; i < 16; ++i) mx = fmaxf(mx, S[i]);
            mx = max_x32(mx);
            if (__any(mx > mrun + 8.0f)) {
                const float mn = fmaxf(mrun, mx);
                const float alpha = __builtin_amdgcn_exp2f(mrun - mn);
                mrun = mn;
                lrun *= alpha;
#pragma unroll
                for (int d = 0; d < 4; ++d) O[d] = O[d] * alpha;
            }
            float ls = 0.f;
#pragma unroll
            for (int i = 0; i < 16; ++i) { const float e = __builtin_amdgcn_exp2f(S[i] - mrun); S[i] = e; ls += e; }
            lrun += ls;
            P[0] = pack8(S, 0); P[1] = pack8(S, 1);
        };
        auto pv_half = [&](const bf16_t* vb, int kh, int dsw, const bf16x8 (&P)[2]) __attribute__((always_inline)) {
#pragma unroll
            for (int s2 = 0; s2 < 2; ++s2) {
                const int u = kh * 2 + s2;
#pragma unroll
                for (int d = 0; d < 4; ++d) {
                    const bf16x8 A = *(const bf16x8*)(vb + (d * 32 + l31) * 64 + (((2 * u + hi) ^ dsw) * 8));
                    O[d] = mfma32(A, P[s2], O[d]);
                }
            }
        };

        __syncthreads();
        dma_tile(0, 0);
        asm volatile("s_waitcnt vmcnt(0)" ::: "memory");
        __syncthreads();
        for (int j = 0; j < ntile; ++j) {
            const int buf = j & 1;
            if (j + 1 < ntile) dma_tile(j + 1, buf ^ 1);
            const int kbase = (j - 1) * 64;
            const bool active = (j == 0) || (kbase <= q0 + 31);
            if (active) {
                const bf16_t* kb = sK + buf * 64 * 128;
                const bf16_t* vb = sV + buf * 128 * 64;
                const bool need_mask = (j == 0) || (kbase + 63 > q0);
                const bool act1 = (j >= 1) && (kbase + 32 <= q0 + 31);
                int ksw = l31 & 15, dsw = (l31 >> 1) & 7;
                asm volatile("" : "+v"(ksw), "+v"(dsw));
                f32x16 S0 = qk_half(kb, 0, ksw);
                bf16x8 P[2];
                if (act1) {
                    f32x16 S1 = qk_half(kb, 1, ksw);
                    softmax_half(S0, j, 0, kbase, need_mask, P);
                    pv_half(vb, 0, dsw, P);
                    softmax_half(S1, j, 1, kbase, need_mask, P);
                    pv_half(vb, 1, dsw, P);
                } else {
                    softmax_half(S0, j, 0, kbase, need_mask, P);
                    pv_half(vb, 0, dsw, P);
                }
            }
            asm volatile("s_waitcnt vmcnt(0)" ::: "memory");
            __syncthreads();
        }
        {
            const float l = sum_x32(lrun);
            float* so = sO + qg * 4096 + lane;
            if (comp == 1) {
                const float sc1 = lam / l;
#pragma unroll
                for (int d = 0; d < 4; ++d)
#pragma unroll
                    for (int i = 0; i < 16; ++i) so[(d * 16 + i) * 64] = O[d][i] * sc1;
            }
            __syncthreads();
            if (comp == 0) {
                const float i0 = 1.0f / l;
                float sq = 0.f;
#pragma unroll
                for (int d = 0; d < 4; ++d)
#pragma unroll
                    for (int i = 0; i < 16; ++i) { const float o = O[d][i] * i0 - so[(d * 16 + i) * 64]; O[d][i] = o; sq += o * o; }
                sq = sum_x32(sq);
                const float sc = rsqrtf(sq * (1.0f / 128.0f) + EPS);
                bf16_t* op = AO + (size_t)(b * 4096 + q0 + l31) * 1024 + head * 128;
#pragma unroll
                for (int d = 0; d < 4; ++d)
#pragma unroll
                    for (int g = 0; g < 4; ++g) {
                        u32x2 w; w.x = pk2(O[d][4 * g] * sc, O[d][4 * g + 1] * sc); w.y = pk2(O[d][4 * g + 2] * sc, O[d][4 * g + 3] * sc);
                        *(u32x2*)(op + d * 32 + 8 * g + 4 * hi) = w;
                    }
            }
        }
    }
}

DI void final_phase(const Params& p) {
    const int tid = tid_fresh(), lane = tid & 63, wid = tid >> 6;
    const float* h = (const float*)(p.ws + OFF_H);
    const float* ss = (const float*)(p.ws + OFF_SS) + 3 * MP;
    for (int r = blockIdx.x * 8 + wid; r < MR; r += gridDim.x * 8) {
        const float rstd = rsqrtf(ss[r] * (1.0f / 1024.0f) + EPS);
#pragma unroll
        for (int i = 0; i < 4; ++i) {
            const int c = i * 256 + lane * 4;
            const f32x4 v = *(const f32x4*)(h + (size_t)r * 1024 + c);
            const f32x4 g = *(const f32x4*)(p.norm_final + c);
            *(f32x4*)(p.out + (size_t)r * 1024 + c) = v * rstd * g;
        }
    }
}

template <class Epi> DI void small_gemm(const bf16_t* A, const bf16_t* Bt, int N, int K, const Epi& E) {
    const int tid = tid_fresh(), lane = tid & 63, wid = tid >> 6, fr = lane & 15, fq = lane >> 4;
    const int nw = gridDim.x * 8;
    for (int tile = blockIdx.x * 8 + wid; tile < (N >> 4); tile += nw) {
        const int n0 = tile * 16;
        f32x4 acc = (f32x4){0.f, 0.f, 0.f, 0.f};
        const bf16_t* ap = A + (size_t)fr * K + fq * 8;
        const bf16_t* bp = Bt + (size_t)(n0 + fr) * K + fq * 8;
#pragma unroll 16
        for (int k = 0; k < K; k += 32) acc = mfma16(*(const bf16x8*)(bp + k), *(const bf16x8*)(ap + k), acc);
        E(acc, fr, n0 + fq * 4, fq);
    }
}
struct SEpiIn0 {
    bf16_t* T1; bf16_t* OG;
    DI void operator()(f32x4 v, int row, int n, int fq) const {
        bf16_t* dst;
        if (n < 4096) dst = T1 + (size_t)(MR + row) * 4096 + n;
        else {
            dst = OG + (size_t)(MR + row) * 2048 + (n - 4096);
            if (n < 5120) {
#pragma unroll
                for (int j = 0; j < 4; ++j) v[j] = sigmoidf_(v[j]);
            } else {
#pragma unroll
                for (int j = 0; j < 4; ++j) v[j] = gelu_tanh(v[j]);
            }
        }
        u32x2 w; w.x = pk2(v[0], v[1]); w.y = pk2(v[2], v[3]);
        *(u32x2*)dst = w;
    }
};
template <int MODE> struct SEpiRes {
    float* h; bf16_t* hb; float* ss; const float* meta;
    DI void operator()(f32x4 acc, int row, int n, int fq) const {
        const size_t r = (size_t)(MR + row);
        const f32x4 rv = MODE == 0 ? *(const f32x4*)(meta + (size_t)row * 1024 + n) : *(const f32x4*)(h + r * 1024 + n);
        const f32x4 v = acc + rv;
        *(f32x4*)(h + r * 1024 + n) = v;
        u32x2 w; w.x = pk2(v[0], v[1]); w.y = pk2(v[2], v[3]);
        *(u32x2*)(hb + r * 1024 + n) = w;
        float sq = v[0] * v[0] + v[1] * v[1] + v[2] * v[2] + v[3] * v[3];
        sq = sum_x16_x32(sq);
        if (fq == 0) atomicAdd(ss + r, sq);
    }
};
struct SEpiUp {
    bf16_t* HID; const float* ss;
    DI void operator()(f32x4 v, int row, int n, int fq) const {
        const size_t r = (size_t)(MR + row);
        const float rstd = rsqrtf(ss[r] * (1.0f / 1024.0f) + EPS);
#pragma unroll
        for (int j = 0; j < 4; ++j) { const float a = fmaxf(v[j] * rstd, 0.f); v[j] = a * a; }
        u32x2 w; w.x = pk2(v[0], v[1]); w.y = pk2(v[2], v[3]);
        *(u32x2*)(HID + r * 4096 + n) = w;
    }
};
struct SEpiQKV {
    bf16_t* QK; bf16_t* VT; const float* ss; const float* rope;
    DI void operator()(f32x4 v, int row, int n, int fq) const {
        const size_t r = (size_t)(MR + row);
        const float rstd = rsqrtf(ss[r] * (1.0f / 1024.0f) + EPS);
#pragma unroll
        for (int j = 0; j < 4; ++j) v[j] *= rstd;
        if (n < 2048) {
            if (((n - fq * 4) & 63) == 0) {
                const f32x4 cs = *(const f32x4*)(rope + row * 16 + (fq & 1) * 4), sn = *(const f32x4*)(rope + row * 16 + 8 + (fq & 1) * 4);
#pragma unroll
                for (int j = 0; j < 4; ++j) {
                    const float other = __shfl_xor(v[j], 32);
                    v[j] = fq < 2 ? v[j] * cs[j] - other * sn[j] : v[j] * cs[j] + other * sn[j];
                }
            }
            u32x2 w; w.x = pk2(v[0], v[1]); w.y = pk2(v[2], v[3]);
            *(u32x2*)(QK + r * 2048 + n) = w;
        } else {
#pragma unroll
            for (int j = 0; j < 4; ++j) VT[(size_t)(n - 2048 + j) * MP + MR + ((row & 3) | ((row & 4) << 1) | ((row & 8) >> 1))] = f2bf(v[j]);
        }
    }
};

#define XB_TMO      128
#define XB_XCNT(j)  (256  + 64 * (j))
#define XB_XSUB(j)  (1280 + 64 * (j))
#define XB_XGEN(j)  (2304 + 64 * (j))
#define XB_TOP      3328
#define XB_TOPGEN   3392
#define XCD_BAR_WORDS 3456
#define XB_SPIN_CAP (1u << 18)
DI unsigned xb_ld(unsigned* p)              { return __hip_atomic_load(p, __ATOMIC_RELAXED, __HIP_MEMORY_SCOPE_AGENT); }
DI unsigned xb_add(unsigned* p, unsigned v) { return __hip_atomic_fetch_add(p, v, __ATOMIC_RELAXED, __HIP_MEMORY_SCOPE_AGENT); }
DI unsigned xb_xcc_id() { return (unsigned)__builtin_amdgcn_s_getreg((3 << 11) | 20) & 0xFu; }
#define XB_SPIN(cond, bar) do { unsigned _sp = 0; while (cond) { __builtin_amdgcn_s_sleep(1); \
    if ((++_sp & 255u) == 0u) { if (xb_ld(&(bar)[XB_TMO])) break; if (_sp > XB_SPIN_CAP) { atomicAdd(&(bar)[XB_TMO], 1u); break; } } } } while (0)
struct XcdBarrier { unsigned* bar; unsigned x; volatile LAS unsigned* st; };
DI XcdBarrier xcd_barrier_post(unsigned* bar, volatile LAS unsigned* st) {
    XcdBarrier b; b.bar = bar; b.x = xb_xcc_id(); b.st = st;
    if (threadIdx.x == 0) (void)xb_add(&bar[XB_XCNT(b.x)], 1u);
    return b;
}
DI void xcd_barrier_complete(unsigned* bar, unsigned x, unsigned& nloc, unsigned& nx) {
    const unsigned G = gridDim.x * gridDim.y * gridDim.z;
    unsigned sum, cnt, mine, sp = 0u;
    for (;;) {
        sum = 0u; cnt = 0u; mine = 0u;
#pragma unroll
        for (unsigned j = 0; j < 16; ++j) { const unsigned c = xb_ld(&bar[XB_XCNT(j)]); sum += c; cnt += (c > 0u) ? 1u : 0u; mine = (j == x) ? c : mine; }
        if (sum == G) break;
        __builtin_amdgcn_s_sleep(1);
        if ((++sp & 255u) == 0u) { if (xb_ld(&bar[XB_TMO])) break; if (sp > XB_SPIN_CAP) { atomicAdd(&bar[XB_TMO], 1u); break; } }
    }
    nloc = mine > 0u ? mine : 1u; nx = cnt > 0u ? cnt : 1u;
}
DI void xcd_barrier(const XcdBarrier& b) {
    asm volatile("s_waitcnt vmcnt(0)" ::: "memory");
    __syncthreads();
    if (threadIdx.x == 0) {
        unsigned* bar = b.bar;
        __builtin_amdgcn_s_waitcnt(0);
        unsigned nloc = b.st[0], nx = b.st[1];
        if (nloc == 0u) { xcd_barrier_complete(bar, b.x, nloc, nx); b.st[0] = nloc; b.st[1] = nx; }
        const unsigned old = xb_add(&bar[XB_XSUB(b.x)], 1u);
        const unsigned gen = old / nloc;
        if (old + 1u == (gen + 1u) * nloc) {
            __builtin_amdgcn_fence(__ATOMIC_RELEASE, "agent");
            asm volatile("s_waitcnt vmcnt(0)" ::: "memory");
            const unsigned og = xb_add(&bar[XB_TOP], 1u);
            const unsigned tg = og / nx;
            if (og + 1u == (tg + 1u) * nx) xb_add(&bar[XB_TOPGEN], 1u);
            else XB_SPIN(xb_ld(&bar[XB_TOPGEN]) == tg, bar);
            __builtin_amdgcn_fence(__ATOMIC_ACQUIRE, "agent");
            xb_add(&bar[XB_XGEN(b.x)], 1u);
            asm volatile("s_waitcnt vmcnt(0)" ::: "memory");
        } else {
            XB_SPIN(xb_ld(&bar[XB_XGEN(b.x)]) == gen, bar);
            __builtin_amdgcn_fence(__ATOMIC_ACQUIRE, "agent");
            asm volatile("s_waitcnt vmcnt(0)" ::: "memory");
        }
    }
    __syncthreads();
}

#ifndef DUP
#define DUP 0
#endif
__global__ void __launch_bounds__(512) fwd_megakernel(Params p) {
    extern __shared__ __attribute__((aligned(16))) unsigned char smem[];
    cg::grid_group grid = cg::this_grid();
    LAS unsigned char* lds = (LAS unsigned char*)smem;
    const int G = gridDim.x, c = blockIdx.x;
    bf16_t* HB = (bf16_t*)(p.ws + OFF_HB);
    float* H = (float*)(p.ws + OFF_H);
    float* SS = (float*)(p.ws + OFF_SS);
    bf16_t* HID = (bf16_t*)(p.ws + OFF_HID);
    pg8::StaticOrder S;

    unsigned* bar = (unsigned*)(p.ws + OFF_BAR);
    volatile LAS unsigned* xst = (volatile LAS unsigned*)(lds + LDS_BYTES - 16);
    if (threadIdx.x == 0) { xst[0] = 0u; xst[1] = 0u; }
    __syncthreads();
    const XcdBarrier xb = xcd_barrier_post(bar, xst);
    if (p.out == nullptr) grid.sync();
    prologue_phase(p, smem);
    xcd_barrier(xb);
#if DUP == 4
    prologue_phase(p, smem);
    xcd_barrier(xb);
#endif
    {
        pg8::Gemm g{HB, (const bf16_t*)(p.ws + OFF_WIN0), MR, 6144, 1024};
        EpiIn0 E{(bf16_t*)(p.ws + OFF_R2), (bf16_t*)(p.ws + OFF_R3)};
        SEpiIn0 Es{(bf16_t*)(p.ws + OFF_R2), (bf16_t*)(p.ws + OFF_R3)};
        small_gemm(HB + (size_t)MR * 1024, g.Bt, 6144, 1024, Es);
        S.init(MR, 6144, G, c); pg8::gemm_phase(lds, g, S, E);
    }
    xcd_barrier(xb);
    mixer0_phase(p, smem);
    xcd_barrier(xb);
#if DUP == 2
    {
        pg8::Gemm g{HB, (const bf16_t*)(p.ws + OFF_WIN0), MR, 6144, 1024};
        EpiIn0 E{(bf16_t*)(p.ws + OFF_R2), (bf16_t*)(p.ws + OFF_R3)};
        SEpiIn0 Es{(bf16_t*)(p.ws + OFF_R2), (bf16_t*)(p.ws + OFF_R3)};
        small_gemm(HB + (size_t)MR * 1024, g.Bt, 6144, 1024, Es);
        S.init(MR, 6144, G, c); pg8::gemm_phase(lds, g, S, E);
        float* z = (float*)(p.ws + OFF_HSS);
        for (int i = blockIdx.x * 512 + threadIdx.x; i < 4 * MP; i += gridDim.x * 512) z[i] = 0.f;
    }
    xcd_barrier(xb);
    mixer0_phase(p, smem);
    xcd_barrier(xb);
#endif
#if DUP == 6 || DUP == 7
    {
        pg8::Gemm g{HB, (const bf16_t*)(p.ws + OFF_WIN0), MR, 6144, 1024};
        EpiIn0 E{(bf16_t*)(p.ws + OFF_R2), (bf16_t*)(p.ws + OFF_R3)};
        SEpiIn0 Es{(bf16_t*)(p.ws + OFF_R2), (bf16_t*)(p.ws + OFF_R3)};
        small_gemm(HB + (size_t)MR * 1024, g.Bt, 6144, 1024, Es);
        S.init(MR, 6144, G, c); pg8::gemm_phase(lds, g, S, E);
        float* z = (float*)(p.ws + OFF_HSS);
        for (int i = blockIdx.x * 512 + threadIdx.x; i < 4 * MP; i += gridDim.x * 512) z[i] = 0.f;
    }
    xcd_barrier(xb);
    mixer0_phase(p, smem, DUP == 6 ? 1 : 2, false);
    xcd_barrier(xb);
    {
        pg8::Gemm g{HB, (const bf16_t*)(p.ws + OFF_WIN0), MR, 6144, 1024};
        EpiIn0 E{(bf16_t*)(p.ws + OFF_R2), (bf16_t*)(p.ws + OFF_R3)};
        SEpiIn0 Es{(bf16_t*)(p.ws + OFF_R2), (bf16_t*)(p.ws + OFF_R3)};
        small_gemm(HB + (size_t)MR * 1024, g.Bt, 6144, 1024, Es);
        S.init(MR, 6144, G, c); pg8::gemm_phase(lds, g, S, E);
        float* z = (float*)(p.ws + OFF_HSS);
        for (int i = blockIdx.x * 512 + threadIdx.x; i < 4 * MP; i += gridDim.x * 512) z[i] = 0.f;
    }
    xcd_barrier(xb);
    mixer0_phase(p, smem, 3, false);
    xcd_barrier(xb);
#endif
    headnorm_phase(p);
    xcd_barrier(xb);
    {
        pg8::Gemm g{(const bf16_t*)(p.ws + OFF_R3), (const bf16_t*)(p.ws + OFF_WOUT0), MR, 1024, 2048};
        EpiRes<0> E{H, HB, SS + 0 * MP, p.x, p.meta};
        SEpiRes<0> Es{H, HB, SS + 0 * MP, p.meta};
        small_gemm(g.A + (size_t)MR * 2048, g.Bt, 1024, 2048, Es);
        S.init(MR, 1024, G, c); pg8::gemm_phase(lds, g, S, E);
    }
    xcd_barrier(xb);
    {
        pg8::Gemm g{HB, (const bf16_t*)(p.ws + OFF_WM10), MR, 4096, 1024};
        EpiUp E{HID, SS + 0 * MP};
        SEpiUp Es{HID, SS + 0 * MP};
        small_gemm(HB + (size_t)MR * 1024, g.Bt, 4096, 1024, Es);
        S.init(MR, 4096, G, c); pg8::gemm_phase(lds, g, S, E);
#if DUP == 3
        xcd_barrier(xb);
        S.init(MR, 4096, G, c); pg8::gemm_phase(lds, g, S, E);
#endif
    }
    xcd_barrier(xb);
    {
        pg8::Gemm g{HID, (const bf16_t*)(p.ws + OFF_WM20), MR, 1024, 4096};
        EpiRes<1> E{H, HB, SS + 1 * MP, nullptr, nullptr};
        SEpiRes<1> Es{H, HB, SS + 1 * MP, nullptr};
        small_gemm(HID + (size_t)MR * 4096, g.Bt, 1024, 4096, Es);
        S.init(MR, 1024, G, c); pg8::gemm_phase(lds, g, S, E);
    }
    xcd_barrier(xb);
    {
        pg8::Gemm g{HB, (const bf16_t*)(p.ws + OFF_WIN1), MR, 2048, 1024};
        EpiQK E{(bf16_t*)(p.ws + OFF_QK1), SS + 1 * MP, (const float*)(p.ws + OFF_ROPE)};
        SEpiQKV Es{(bf16_t*)(p.ws + OFF_QK1), (bf16_t*)(p.ws + OFF_VT), SS + 1 * MP, (const float*)(p.ws + OFF_ROPE)};
        small_gemm(HB + (size_t)MR * 1024, g.Bt, 3072, 1024, Es);
        {
            bf16_t* QKz = (bf16_t*)(p.ws + OFF_QK1); bf16_t* VTz = (bf16_t*)(p.ws + OFF_VT);
            for (int i = blockIdx.x * 512 + threadIdx.x; i < 48 * 128; i += gridDim.x * 512)
                *(u32x4*)(QKz + (size_t)(MR + 16 + (i >> 7)) * 2048 + 1024 + (i & 127) * 8) = (u32x4){0u, 0u, 0u, 0u};
            for (int i = blockIdx.x * 512 + threadIdx.x; i < 1024 * 6; i += gridDim.x * 512)
                *(u32x4*)(VTz + (size_t)(i / 6) * MP + MR + 16 + (i % 6) * 8) = (u32x4){0u, 0u, 0u, 0u};
        }
        S.init(MR, 2048, G, c); pg8::gemm_phase(lds, g, S, E);
        pg8::Gemm g2{(const bf16_t*)(p.ws + OFF_WIN1) + 2048ull * 1024, HB, 1024, MR, 1024};
        EpiVT E2{(bf16_t*)(p.ws + OFF_VT), SS + 1 * MP};
        S.init(1024, MR, G, c); pg8::gemm_phase(lds, g2, S, E2);
    }
    xcd_barrier(xb);
    attn_phase(p, smem);
    xcd_barrier(xb);
#if DUP == 1
    attn_phase(p, smem);
    xcd_barrier(xb);
#endif
    {
        pg8::Gemm g{(const bf16_t*)(p.ws + OFF_AO), (const bf16_t*)(p.ws + OFF_WOUT1), MR, 1024, 1024};
        EpiRes<1> E{H, HB, SS + 2 * MP, nullptr, nullptr};
        S.init(MR, 1024, G, c); pg8::gemm_phase(lds, g, S, E);
    }
    xcd_barrier(xb);
    {
        pg8::Gemm g{HB, (const bf16_t*)(p.ws + OFF_WM11), MR, 4096, 1024};
        EpiUp E{HID, SS + 2 * MP};
        S.init(MR, 4096, G, c); pg8::gemm_phase(lds, g, S, E);
    }
    xcd_barrier(xb);
    {
        pg8::Gemm g{HID, (const bf16_t*)(p.ws + OFF_WM21), MR, 1024, 4096};
        EpiRes<1, false> E{H, HB, SS + 3 * MP, nullptr, nullptr};
        S.init(MR, 1024, G, c); pg8::gemm_phase(lds, g, S, E);
    }
    xcd_barrier(xb);
#if DUP == 8
#pragma unroll 1
    for (int i = 0; i < 20; ++i) xcd_barrier(xb);
#endif
    final_phase(p);
#if DUP == 5
    xcd_barrier(xb);
    {
        pg8::Gemm g{HID, (const bf16_t*)(p.ws + OFF_WM21), MR, 1024, 4096};
        EpiRes<1> E{H, HB, SS + 3 * MP, nullptr, nullptr};
        S.init(MR, 1024, G, c); pg8::gemm_phase(lds, g, S, E);
    }
#endif
}

extern "C" void kernel_launch(void* const* d_in, const int* in_sizes, int n_in, void* d_out, int out_size, void* d_ws, size_t ws_size, hipStream_t stream) {
    static int grid_blocks = 0;
    if (!grid_blocks) {
        int dev = 0, cus = 0, per_cu = 0;
        hipGetDevice(&dev);
        hipDeviceGetAttribute(&cus, hipDeviceAttributeMultiprocessorCount, dev);
        hipFuncSetAttribute((const void*)fwd_megakernel, hipFuncAttributeMaxDynamicSharedMemorySize, LDS_BYTES);
        hipOccupancyMaxActiveBlocksPerMultiprocessor(&per_cu, fwd_megakernel, 512, LDS_BYTES);
        if (per_cu < 1) per_cu = 1;
        grid_blocks = cus * per_cu;
        if (grid_blocks > 256) grid_blocks = 256;
    }
    Params p{};
    const float** f = (const float**)&p;
    for (int i = 0; i < 22; ++i) f[i] = (const float*)d_in[i];
    p.out = (float*)d_out;
    p.ws = (unsigned char*)d_ws;
    void* args[] = {&p};
    (void)hipMemsetAsync((unsigned char*)d_ws + OFF_BAR, 0, XCD_BAR_WORDS * sizeof(unsigned), stream);
    hipError_t e = hipLaunchCooperativeKernel((const void*)fwd_megakernel, dim3(grid_blocks), dim3(512), args, LDS_BYTES, stream);
    if (e != hipSuccess) fprintf(stderr, "cooperative launch failed: %s (grid %d)\n", hipGetErrorString(e), grid_blocks);
}
```

```cpp
#include <hip/hip_runtime.h>
#include <hip/hip_cooperative_groups.h>
#include <cstdio>
#include <cstdint>
namespace cg = cooperative_groups;

#define LAS __attribute__((address_space(3)))
#define DI __device__ __forceinline__
typedef unsigned short bf16_t;
typedef short bf16x8 __attribute__((ext_vector_type(8)));
typedef short bf16x4 __attribute__((ext_vector_type(4)));
typedef float f32x4 __attribute__((ext_vector_type(4)));
typedef float f32x2 __attribute__((ext_vector_type(2)));
typedef float f32x16 __attribute__((ext_vector_type(16)));
typedef unsigned u32x4 __attribute__((ext_vector_type(4)));
typedef unsigned u32x2 __attribute__((ext_vector_type(2)));
typedef __bf16 hbf2 __attribute__((ext_vector_type(2)));

constexpr int MR = 32768;
constexpr int MV = 32896;
constexpr int MP = 33024;
constexpr int TSEQ = 4112;
constexpr float EPS = 1e-6f;
constexpr float LAMBDA_INIT = 0.35550906759096934f;
constexpr float LOG2E = 1.4426950408889634f;

constexpr size_t OFF_WIN0 = 0;
constexpr size_t OFF_WOUT0 = OFF_WIN0 + 6144ull * 1024 * 2;
constexpr size_t OFF_WM10 = OFF_WOUT0 + 1024ull * 2048 * 2;
constexpr size_t OFF_WM20 = OFF_WM10 + 4096ull * 1024 * 2;
constexpr size_t OFF_WIN1 = OFF_WM20 + 4096ull * 1024 * 2;
constexpr size_t OFF_WOUT1 = OFF_WIN1 + 3072ull * 1024 * 2;
constexpr size_t OFF_WM11 = OFF_WOUT1 + 1024ull * 1024 * 2;
constexpr size_t OFF_WM21 = OFF_WM11 + 4096ull * 1024 * 2;
constexpr size_t OFF_WLRU = OFF_WM21 + 4096ull * 1024 * 2;
constexpr size_t OFF_LI = OFF_WLRU + 2ull * 8 * 128 * 128 * 2;
constexpr size_t OFF_LF = OFF_LI + (size_t)MP * 16;
constexpr size_t OFF_SS = OFF_LF + (size_t)MP * 16;
constexpr size_t OFF_HSS = OFF_SS + 4ull * MP * 4;
constexpr size_t OFF_ROPE = OFF_HSS + (size_t)MP * 16;
constexpr size_t OFF_MISC = OFF_ROPE + (size_t)TSEQ * 64;
constexpr size_t OFF_BAR = OFF_MISC + 256;
constexpr size_t OFF_HB = OFF_BAR + 13824;
constexpr size_t OFF_R2 = OFF_HB + (size_t)MP * 2048;
constexpr size_t OFF_R3 = OFF_R2 + (size_t)MP * 8192;
constexpr size_t WS_END = OFF_R3 + (size_t)MP * 4096;
constexpr size_t OFF_H = OFF_R2;
constexpr size_t OFF_HID = OFF_R2 + (size_t)MP * 4096;
constexpr size_t OFF_QK1 = OFF_HID;
constexpr size_t OFF_VT = OFF_R3;
constexpr size_t OFF_AO = OFF_R3 + (size_t)MP * 2048;
static_assert(WS_END <= 536870912ull, "workspace");

constexpr int LDS_BYTES = 163840;

struct Params {
    const float *x, *meta, *norm_mix, *norm_mlp, *norm_final, *ab_w_in, *ab_if_bias, *mlstm_norm, *conv_w, *conv_b,
        *w_r, *b_r, *w_i, *b_i, *lam, *ab_w_out, *c_w_in, *c_lambda, *c_subln, *c_w_out, *mlp_w1, *mlp_w2;
    float* out;
    unsigned char* ws;
};

DI unsigned pk2(float a, float b) { f32x2 v = {a, b}; hbf2 r = __builtin_convertvector(v, hbf2); return __builtin_bit_cast(unsigned, r); }
DI bf16_t f2bf(float a) { return (bf16_t)(pk2(a, 0.f) & 0xffffu); }
DI float bf2f(bf16_t b) { return __uint_as_float(((unsigned)b) << 16); }
DI float bflo(unsigned u) { return __uint_as_float(u << 16); }
DI float bfhi(unsigned u) { return __uint_as_float(u & 0xffff0000u); }
DI float sigmoidf_(float x) { return __builtin_amdgcn_rcpf(1.0f + __expf(-x)); }
DI float gelu_tanh(float x) { const float z = 1.5957691216057308f * (x + 0.044715f * x * x * x); return x * sigmoidf_(z); }
DI int tid_fresh() { int t = threadIdx.x; asm volatile("" : "+v"(t)); return t; }
DI float sum_x32(float x) { auto r = __builtin_amdgcn_permlane32_swap(__float_as_uint(x), __float_as_uint(x), false, false); return __uint_as_float(r[0]) + __uint_as_float(r[1]); }
DI float max_x32(float x) { auto r = __builtin_amdgcn_permlane32_swap(__float_as_uint(x), __float_as_uint(x), false, false); return fmaxf(__uint_as_float(r[0]), __uint_as_float(r[1])); }
DI float sum_x16(float x) { auto r = __builtin_amdgcn_permlane16_swap(__float_as_uint(x), __float_as_uint(x), false, false); return __uint_as_float(r[0]) + __uint_as_float(r[1]); }
DI float sum_x16_x32(float x) { return sum_x32(sum_x16(x)); }

DI float wave_sum(float v) {
#pragma unroll
    for (int o = 32; o >= 1; o >>= 1) v += __shfl_xor(v, o);
    return v;
}

template <int CTRL, int ROWMASK> DI float dpp_mov(float old, float src) {
    return __builtin_bit_cast(float, __builtin_amdgcn_update_dpp(__builtin_bit_cast(int, old), __builtin_bit_cast(int, src), CTRL, ROWMASK, 0xf, false));
}
DI float wave_scan_add(float x) {
    x += dpp_mov<0x111, 0xf>(0.f, x); x += dpp_mov<0x112, 0xf>(0.f, x); x += dpp_mov<0x114, 0xf>(0.f, x); x += dpp_mov<0x118, 0xf>(0.f, x);
    x += dpp_mov<0x142, 0xa>(0.f, x); x += dpp_mov<0x143, 0xc>(0.f, x);
    return x;
}
DI float wave_scan_max(float x) {
    const float ninf = -INFINITY;
    x = fmaxf(x, dpp_mov<0x111, 0xf>(ninf, x)); x = fmaxf(x, dpp_mov<0x112, 0xf>(ninf, x)); x = fmaxf(x, dpp_mov<0x114, 0xf>(ninf, x)); x = fmaxf(x, dpp_mov<0x118, 0xf>(ninf, x));
    x = fmaxf(x, dpp_mov<0x142, 0xa>(ninf, x)); x = fmaxf(x, dpp_mov<0x143, 0xc>(ninf, x));
    return x;
}

namespace pg8 {
constexpr int BM = 256, BK = 64, HALF = 128, HTB = HALF * BK * 2, STAGE_BYTES = 8 * HTB, NXCD = 8, WGM = 8;
__host__ __device__ __forceinline__ int lds_byte(int r, int c) { const int st = (r >> 4) * 2 + (c >> 5), rr = r & 15, cc = c & 31, ob = rr * 64 + cc * 2; return st * 1024 + (ob ^ (((ob >> 9) & 1) << 5)); }
__host__ __device__ __forceinline__ void stage_rc(int b, int& R, int& C) { const int st = b / 1024, sb = b % 1024, swz = sb ^ (((sb >> 9) & 1) << 5); R = (st >> 1) * 16 + swz / 64; C = (st & 1) * 32 + (swz % 64) / 2; }
__host__ __device__ __forceinline__ int perm32(int rho) { const int n = rho >> 4, i = rho & 15; return 8 * (i >> 2) + 4 * n + (i & 3); }
struct Unit { int pm, pn; };
struct Gemm { const bf16_t* A; const bf16_t* Bt; int M, N, K; };
struct StaticOrder {
    int nM, nN, nwg, G, c;
    __device__ void init(int M, int N, int G_, int c_) { nM = M / BM; nN = N / BM; nwg = nM * nN; G = G_; c = c_; }
    __device__ bool next(int i, Unit& u) const {
        const long L = (long)i * G + c; if (L >= nwg) return false;
        int wgid = (int)L; { const int q = nwg / NXCD, r = nwg % NXCD, xcd = wgid % NXCD, off = wgid / NXCD; wgid = (xcd < r ? xcd * (q + 1) : r * (q + 1) + (xcd - r) * q) + off; }
        const int nig = WGM * nN, gid = wgid / nig, fm = gid * WGM, gsz = (nM - fm) < WGM ? (nM - fm) : WGM;
        u.pm = fm + ((wgid % nig) % gsz); u.pn = (wgid % nig) / gsz; return true;
    }
};

template <class Epi>
__device__ __forceinline__ void gemm_phase(LAS unsigned char* lds, const Gemm g, const StaticOrder& S, const Epi& E) {
    const int tid = tid_fresh(), wid = __builtin_amdgcn_readfirstlane(tid >> 6), lane = tid & 63, wr = wid >> 2, wc = wid & 3, fr = lane & 15, fq = lane >> 4;
    const int K = g.K, nt = K / BK;
    unsigned voffA[2], voffB[2];
#pragma unroll
    for (int i = 0; i < 2; ++i) { int R, C; stage_rc(tid * 16 + i * 8192, R, C); const int Rb = Epi::PERM ? ((R & ~31) + perm32(R & 31)) : R;
        voffA[i] = (unsigned)(R * K + C) * 2u; voffB[i] = (unsigned)(Rb * K + C) * 2u; }
    const size_t kstep = (size_t)(BK * 2);
    const size_t hstep = (size_t)HALF * K * 2;
    const size_t tstep = 2 * hstep;
    const unsigned ldsw = (unsigned)wid * 1024u;
    const int aoff = lds_byte(wr * 64 + fr, fq * 8), boff = lds_byte(wc * 32 + fr, fq * 8);
#define PG8_SA(b, h) (((b) * 2 + (h)) * HTB)
#define PG8_SB(b, h) ((4 + (b) * 2 + (h)) * HTB)
#define PG8_STAGE(bufoff, gbase, voff) do { _Pragma("unroll") for (int _i = 0; _i < 2; ++_i) \
        __builtin_amdgcn_global_load_lds((const unsigned*)((const char*)(gbase) + (voff)[_i]), (LAS unsigned*)(lds + (bufoff) + ldsw + _i * 8192), 16, 0, 0); } while (0)
#define PG8_LDA(dst, b, h) do { _Pragma("unroll") for (int m = 0; m < 4; ++m) _Pragma("unroll") for (int k = 0; k < 2; ++k) dst[m][k] = *(const LAS bf16x8*)(lds + PG8_SA(b, h) + aoff + m * 2048 + k * 1024); } while (0)
#define PG8_LDB(dst, b, h) do { _Pragma("unroll") for (int n = 0; n < 2; ++n) _Pragma("unroll") for (int k = 0; k < 2; ++k) dst[n][k] = *(const LAS bf16x8*)(lds + PG8_SB(b, h) + boff + n * 2048 + k * 1024); } while (0)
#define PG8_MMA(ai, bj, At, Bt) do { __builtin_amdgcn_s_setprio(1); _Pragma("unroll") for (int m = 0; m < 4; ++m) _Pragma("unroll") for (int n = 0; n < 2; ++n) _Pragma("unroll") for (int k = 0; k < 2; ++k) \
        acc[ai][bj][m][n] = __builtin_amdgcn_mfma_f32_16x16x32_bf16(Bt[n][k], At[m][k], acc[ai][bj][m][n], 0, 0, 0); __builtin_amdgcn_s_setprio(0); } while (0)
#define PG8_WAIT_V(n) asm volatile("s_waitcnt vmcnt(" #n ")" ::: "memory")
#define PG8_WAIT_L(n) asm volatile("s_waitcnt lgkmcnt(" #n ")" ::: "memory")
#define PG8_BAR __builtin_amdgcn_s_barrier()
#define PG8_SCHED __builtin_amdgcn_sched_barrier(0)
    Unit cur, nxt; int ui = 0;
    if (!S.next(0, cur)) return;
    f32x4 acc[2][2][4][2];
#pragma unroll
    for (int a = 0; a < 2; ++a)
#pragma unroll
        for (int b = 0; b < 2; ++b)
#pragma unroll
            for (int m = 0; m < 4; ++m)
#pragma unroll
                for (int n = 0; n < 2; ++n) acc[a][b][m][n] = (f32x4){0.f, 0.f, 0.f, 0.f};
    bf16x8 At[4][2], B0[2][2], B1[2][2];
    const char* cA = (const char*)g.A + (size_t)cur.pm * tstep; const char* cB = (const char*)g.Bt + (size_t)cur.pn * tstep;
    PG8_STAGE(PG8_SB(0, 0), cB, voffB); PG8_STAGE(PG8_SA(0, 0), cA, voffA); PG8_STAGE(PG8_SB(0, 1), cB + hstep, voffB); PG8_STAGE(PG8_SA(0, 1), cA + hstep, voffA);
    if (wr == 1) PG8_BAR;
    PG8_WAIT_V(4); PG8_BAR;
    PG8_STAGE(PG8_SB(1, 0), cB + kstep, voffB); PG8_STAGE(PG8_SA(1, 0), cA + kstep, voffA); PG8_STAGE(PG8_SB(1, 1), cB + hstep + kstep, voffB);
    PG8_WAIT_V(6); PG8_BAR;
    for (;;) {
        const bool has_next = S.next(ui + 1, nxt);
        const char* nA = has_next ? (const char*)g.A + (size_t)nxt.pm * tstep : cA; const char* nB = has_next ? (const char*)g.Bt + (size_t)nxt.pn * tstep : cB;
        for (int t = 0; t < nt; t += 2) {
            const bool last = (t == nt - 2);
            const char* a1 = cA + (size_t)(t + 1) * kstep;
            const char* a2 = last ? nA : cA + (size_t)(t + 2) * kstep; const char* b2 = last ? nB : cB + (size_t)(t + 2) * kstep;
            const char* a3 = a2 + kstep; const char* b3 = b2 + kstep;
            PG8_LDB(B0, 0, 0); PG8_SCHED; PG8_LDA(At, 0, 0); PG8_STAGE(PG8_SA(1, 1), a1 + hstep, voffA);
            PG8_WAIT_L(8); PG8_BAR; PG8_WAIT_L(0); PG8_MMA(0, 0, At, B0); PG8_BAR; PG8_SCHED;
            PG8_LDB(B1, 0, 1); PG8_STAGE(PG8_SB(0, 0), b2, voffB);
            PG8_BAR; PG8_WAIT_L(0); PG8_MMA(0, 1, At, B1); PG8_BAR;
            PG8_LDA(At, 0, 1); PG8_STAGE(PG8_SA(0, 0), a2, voffA);
            PG8_BAR; PG8_WAIT_L(0); PG8_MMA(1, 0, At, B0); PG8_BAR; PG8_SCHED;
            PG8_STAGE(PG8_SB(0, 1), b2 + hstep, voffB);
            PG8_WAIT_V(6); PG8_BAR; PG8_MMA(1, 1, At, B1); PG8_BAR;
            PG8_LDB(B0, 1, 0); PG8_SCHED; PG8_LDA(At, 1, 0); PG8_STAGE(PG8_SA(0, 1), a2 + hstep, voffA);
            PG8_WAIT_L(8); PG8_BAR; PG8_WAIT_L(0); PG8_MMA(0, 0, At, B0); PG8_BAR; PG8_SCHED;
            PG8_LDB(B1, 1, 1); PG8_STAGE(PG8_SB(1, 0), b3, voffB);
            PG8_BAR; PG8_WAIT_L(0); PG8_MMA(0, 1, At, B1); PG8_BAR;
            PG8_LDA(At, 1, 1); PG8_STAGE(PG8_SA(1, 0), a3, voffA);
            PG8_BAR; PG8_WAIT_L(0); PG8_MMA(1, 0, At, B0); PG8_BAR; PG8_SCHED;
            PG8_STAGE(PG8_SB(1, 1), b3 + hstep, voffB);
            PG8_WAIT_V(6); PG8_BAR; PG8_MMA(1, 1, At, B1); PG8_BAR;
        }
        E(acc, cur, wr, wc, fr, fq);
        if (!has_next) break;
#pragma unroll
        for (int a = 0; a < 2; ++a)
#pragma unroll
            for (int b = 0; b < 2; ++b)
#pragma unroll
                for (int m = 0; m < 4; ++m)
#pragma unroll
                    for (int n = 0; n < 2; ++n) acc[a][b][m][n] = (f32x4){0.f, 0.f, 0.f, 0.f};
        cur = nxt; cA = nA; cB = nB; ++ui;
    }
    PG8_WAIT_V(0);
    if (wr == 0) PG8_BAR;
    PG8_BAR;
#undef PG8_SA
#undef PG8_SB
#undef PG8_STAGE
#undef PG8_LDA
#undef PG8_LDB
#undef PG8_MMA
#undef PG8_WAIT_V
#undef PG8_WAIT_L
#undef PG8_BAR
#undef PG8_SCHED
}
}
using pg8::Unit;

struct EpiIn0 {
    static constexpr bool PERM = true;
    bf16_t* T1; bf16_t* OG;
    DI void operator()(const f32x4 (&acc)[2][2][4][2], const Unit& u, int wr, int wc, int fr, int fq) const {
        const int row0 = u.pm * 256 + wr * 64 + fr;
        bf16_t* base; int ldc, colt, act;
        if (u.pn < 16) { base = T1; ldc = 4096; colt = u.pn * 256; act = 0; }
        else { base = OG; ldc = 2048; colt = (u.pn - 16) * 256; act = (u.pn < 20) ? 1 : 2; }
        const int col0 = colt + wc * 32 + 8 * fq;
#pragma unroll
        for (int ai = 0; ai < 2; ++ai)
#pragma unroll
            for (int m = 0; m < 4; ++m) {
                bf16_t* rowp = base + (size_t)(row0 + ai * 128 + m * 16) * ldc + col0;
#pragma unroll
                for (int bj = 0; bj < 2; ++bj) {
                    f32x4 v0 = acc[ai][bj][m][0], v1 = acc[ai][bj][m][1];
                    if (act == 1) {
#pragma unroll
                        for (int j = 0; j < 4; ++j) { v0[j] = sigmoidf_(v0[j]); v1[j] = sigmoidf_(v1[j]); }
                    } else if (act == 2) {
#pragma unroll
                        for (int j = 0; j < 4; ++j) { v0[j] = gelu_tanh(v0[j]); v1[j] = gelu_tanh(v1[j]); }
                    }
                    u32x4 w; w.x = pk2(v0[0], v0[1]); w.y = pk2(v0[2], v0[3]); w.z = pk2(v1[0], v1[1]); w.w = pk2(v1[2], v1[3]);
                    *(u32x4*)(rowp + bj * 128) = w;
                }
            }
    }
};

template <int MODE, bool WRITE_HB = true>
struct EpiRes {
    static constexpr bool PERM = false;
    float* h; bf16_t* hb; float* ss; const float* x; const float* meta;
    DI void operator()(const f32x4 (&acc)[2][2][4][2], const Unit& u, int wr, int wc, int fr, int fq) const {
        const int row0 = u.pm * 256 + wr * 64 + fr, col0 = u.pn * 256 + wc * 32 + 4 * fq;
#pragma unroll
        for (int ai = 0; ai < 2; ++ai)
#pragma unroll
            for (int m = 0; m < 4; ++m) {
                const int r = row0 + ai * 128 + m * 16;
                const float* rp;
                if (MODE == 0) rp = x + (size_t)r * 1024;
                else rp = h + (size_t)r * 1024;
                float sq = 0.f;
#pragma unroll
                for (int bj = 0; bj < 2; ++bj)
#pragma unroll
                    for (int n = 0; n < 2; ++n) {
                        const int c = col0 + bj * 128 + n * 16;
                        f32x4 rv = rp ? *(const f32x4*)(rp + c) : (f32x4){0.f, 0.f, 0.f, 0.f};
                        f32x4 v = acc[ai][bj][m][n] + rv;
                        *(f32x4*)(h + (size_t)r * 1024 + c) = v;
                        if (WRITE_HB) {
                            u32x2 w; w.x = pk2(v[0], v[1]); w.y = pk2(v[2], v[3]);
                            *(u32x2*)(hb + (size_t)r * 1024 + c) = w;
                        }
                        sq += v[0] * v[0] + v[1] * v[1] + v[2] * v[2] + v[3] * v[3];
                    }
                sq = sum_x16_x32(sq);
                if (fq == 0) atomicAdd(ss + r, sq);
            }
    }
};

struct EpiUp {
    static constexpr bool PERM = true;
    bf16_t* HID; const float* ss;
    DI void operator()(const f32x4 (&acc)[2][2][4][2], const Unit& u, int wr, int wc, int fr, int fq) const {
        const int row0 = u.pm * 256 + wr * 64 + fr, col0 = u.pn * 256 + wc * 32 + 8 * fq;
#pragma unroll
        for (int ai = 0; ai < 2; ++ai)
#pragma unroll
            for (int m = 0; m < 4; ++m) {
                const int r = row0 + ai * 128 + m * 16;
                const float rstd = rsqrtf(ss[r] * (1.0f / 1024.0f) + EPS);
                bf16_t* rowp = HID + (size_t)r * 4096 + col0;
#pragma unroll
                for (int bj = 0; bj < 2; ++bj) {
                    f32x4 v0 = acc[ai][bj][m][0] * rstd, v1 = acc[ai][bj][m][1] * rstd;
#pragma unroll
                    for (int j = 0; j < 4; ++j) { float a = fmaxf(v0[j], 0.f), b = fmaxf(v1[j], 0.f); v0[j] = a * a; v1[j] = b * b; }
                    u32x4 w; w.x = pk2(v0[0], v0[1]); w.y = pk2(v0[2], v0[3]); w.z = pk2(v1[0], v1[1]); w.w = pk2(v1[2], v1[3]);
                    *(u32x4*)(rowp + bj * 128) = w;
                }
            }
    }
};

struct EpiQK {
    static constexpr bool PERM = true;
    bf16_t* QK; const float* ss; const float* rope;
    DI void operator()(const f32x4 (&acc)[2][2][4][2], const Unit& u, int wr, int wc, int fr, int fq) const {
        const int row0 = u.pm * 256 + wr * 64 + fr, col0 = u.pn * 256 + wc * 32 + 8 * fq;
        const bool rot = (wc & 1) == 0;
#pragma unroll
        for (int ai = 0; ai < 2; ++ai)
#pragma unroll
            for (int m = 0; m < 4; ++m) {
                const int r = row0 + ai * 128 + m * 16;
                const float rstd = rsqrtf(ss[r] * (1.0f / 1024.0f) + EPS);
                const int t = r < MR ? 16 + (r & 4095) : ((r - MR) & 15);
                f32x4 cs[2], sn[2];
                if (rot) {
                    cs[0] = *(const f32x4*)(rope + t * 16); cs[1] = *(const f32x4*)(rope + t * 16 + 4);
                    sn[0] = *(const f32x4*)(rope + t * 16 + 8); sn[1] = *(const f32x4*)(rope + t * 16 + 12);
                }
                bf16_t* rowp = QK + (size_t)r * 2048 + col0;
#pragma unroll
                for (int bj = 0; bj < 2; ++bj) {
                    f32x4 v[2]; v[0] = acc[ai][bj][m][0] * rstd; v[1] = acc[ai][bj][m][1] * rstd;
                    if (rot) {
#pragma unroll
                        for (int n = 0; n < 2; ++n)
#pragma unroll
                            for (int j = 0; j < 4; ++j) {
                                const auto sw = __builtin_amdgcn_permlane16_swap(__float_as_uint(v[n][j]), __float_as_uint(v[n][j]), false, false);
                                const float other = __uint_as_float((fq & 1) ? sw[0] : sw[1]);
                                const float mine = v[n][j];
                                const float ra = mine * cs[n][j] - other * sn[n][j];
                                const float rb = mine * cs[n][j] + other * sn[n][j];
                                v[n][j] = fq == 0 ? ra : (fq == 1 ? rb : mine);
                            }
                    }
                    u32x4 w; w.x = pk2(v[0][0], v[0][1]); w.y = pk2(v[0][2], v[0][3]); w.z = pk2(v[1][0], v[1][1]); w.w = pk2(v[1][2], v[1][3]);
                    *(u32x4*)(rowp + bj * 128) = w;
                }
            }
    }
};

struct EpiVT {
    static constexpr bool PERM = true;
    bf16_t* VT; const float* ss;
    DI void operator()(const f32x4 (&acc)[2][2][4][2], const Unit& u, int wr, int wc, int fr, int fq) const {
        const int row0 = u.pm * 256 + wr * 64 + fr, col0 = u.pn * 256 + wc * 32 + 8 * fq;
        f32x4 rs[2][2];
#pragma unroll
        for (int bj = 0; bj < 2; ++bj)
#pragma unroll
            for (int n = 0; n < 2; ++n) {
                f32x4 s = *(const f32x4*)(ss + col0 + bj * 128 + 4 * n);
#pragma unroll
                for (int j = 0; j < 4; ++j) rs[bj][n][j] = rsqrtf(s[j] * (1.0f / 1024.0f) + EPS);
            }
#pragma unroll
        for (int ai = 0; ai < 2; ++ai)
#pragma unroll
            for (int m = 0; m < 4; ++m) {
                bf16_t* rowp = VT + (size_t)(row0 + ai * 128 + m * 16) * MP + col0;
#pragma unroll
                for (int bj = 0; bj < 2; ++bj) {
                    f32x4 v0 = acc[ai][bj][m][0] * rs[bj][0], v1 = acc[ai][bj][m][1] * rs[bj][1];
                    bf16_t* g16 = rowp + bj * 128 - 8 * (fq & 1);
                    u32x2 w0; w0.x = pk2(v0[0], v0[1]); w0.y = pk2(v0[2], v0[3]);
                    u32x2 w1; w1.x = pk2(v1[0], v1[1]); w1.y = pk2(v1[2], v1[3]);
                    *(u32x2*)(g16 + ((fq & 1) ? 4 : 0)) = w0;
                    *(u32x2*)(g16 + ((fq & 1) ? 12 : 8)) = w1;
                }
            }
    }
};

DI float wt_kscale(const Params& p, int job, int k) {
    switch (job) {
        case 0: return p.norm_mix[k];
        case 1: return k < 1024 ? p.mlstm_norm[k] : 1.0f;
        case 2: return p.norm_mlp[k];
        case 4: return p.norm_mix[1024 + k];
        case 5: return p.c_subln[k & 127] * (1.0f - LAMBDA_INIT);
        case 6: return p.norm_mlp[1024 + k];
        default: return 1.0f;
    }
}
DI void wt_colmap(int job, int n, int& scol, float& cs) {
    scol = n; cs = 1.0f;
    if (job == 0) {
        if (n < 3072) { cs = (n >= 1024 && n < 2048) ? 0.0625f : 1.0f; }
        else if (n < 4096) scol = n + 1032;
        else if (n < 5120) scol = n - 1024;
        else scol = n + 8;
    } else if (job == 4) {
        if (n < 1024) cs = 0.125f * LOG2E;
    }
}

DI void wt_convert(const Params& p, unsigned char* smem, int job_lo, int job_hi, int bid, int nblk) {
    const int tid = tid_fresh();
    float* tile = (float*)smem;
    for (int job = job_lo; job < job_hi; ++job) {
        const float* src; int ld, K, N; size_t off;
        switch (job) {
            case 0: src = p.ab_w_in; ld = 6152; K = 1024; N = 6144; off = OFF_WIN0; break;
            case 1: src = p.ab_w_out; ld = 1024; K = 2048; N = 1024; off = OFF_WOUT0; break;
            case 2: src = p.mlp_w1; ld = 4096; K = 1024; N = 4096; off = OFF_WM10; break;
            case 3: src = p.mlp_w2; ld = 1024; K = 4096; N = 1024; off = OFF_WM20; break;
            case 4: src = p.c_w_in; ld = 3072; K = 1024; N = 3072; off = OFF_WIN1; break;
            case 5: src = p.c_w_out; ld = 1024; K = 1024; N = 1024; off = OFF_WOUT1; break;
            case 6: src = p.mlp_w1 + 1024ull * 4096; ld = 4096; K = 1024; N = 4096; off = OFF_WM11; break;
            default: src = p.mlp_w2 + 4096ull * 1024; ld = 1024; K = 4096; N = 1024; off = OFF_WM21; break;
        }
        bf16_t* dst = (bf16_t*)(p.ws + off);
        const int tn = N / 256, tk = K / 64;
        for (int t = bid; t < tn * tk; t += nblk) {
            const int n0 = (t % tn) * 256, k0 = (t / tn) * 64;
            {
                const int tx = tid & 63, ty = tid >> 6;
                float ksc[8];
#pragma unroll
                for (int i = 0; i < 8; ++i) ksc[i] = wt_kscale(p, job, k0 + ty * 8 + i);
#pragma unroll
                for (int cg = 0; cg < 4; ++cg) {
                    int scol; float cs; wt_colmap(job, n0 + cg * 64 + tx, scol, cs);
#pragma unroll
                    for (int i = 0; i < 8; ++i) tile[(ty * 8 + i) * 257 + cg * 64 + tx] = src[(size_t)(k0 + ty * 8 + i) * ld + scol] * (cs * ksc[i]);
                }
            }
            __syncthreads();
#pragma unroll
            for (int q = 0; q < 4; ++q) {
                const int vid = tid + 512 * q, nl = vid >> 3, ks = vid & 7;
                float v[8];
#pragma unroll
                for (int j = 0; j < 8; ++j) v[j] = tile[(ks * 8 + j) * 257 + nl];
                u32x4 w; w.x = pk2(v[0], v[1]); w.y = pk2(v[2], v[3]); w.z = pk2(v[4], v[5]); w.w = pk2(v[6], v[7]);
                *(u32x4*)(dst + (size_t)(n0 + nl) * K + k0 + ks * 8) = w;
            }
            __syncthreads();
        }
    }
}

DI void prologue_phase(const Params& p, unsigned char* smem) {
    const int tid = tid_fresh(), lane = tid & 63, wid = tid >> 6;
    wt_convert(p, smem, 0, 1, blockIdx.x, gridDim.x);
    {
        bf16_t* dst = (bf16_t*)(p.ws + OFF_WLRU);
        for (int i = blockIdx.x * 512 + tid; i < 2 * 8 * 128 * 128; i += gridDim.x * 512) {
            const int d = i & 127, e = (i >> 7) & 127, which = (i >> 14) & 1, n = i >> 15;
            const float* w = which ? p.w_i : p.w_r;
            dst[i] = f2bf(w[(n * 128 + d) * 128 + e]);
        }
    }
    if (blockIdx.x == 0 && wid == 0) {
        const float a = wave_sum(p.c_lambda[lane] * p.c_lambda[64 + lane]);
        const float c = wave_sum(p.c_lambda[128 + lane] * p.c_lambda[192 + lane]);
        if (lane == 0) ((float*)(p.ws + OFF_MISC))[0] = expf(a) - expf(c) + LAMBDA_INIT;
    }
    {
        float* z = (float*)(p.ws + OFF_SS);
        for (int i = blockIdx.x * 512 + tid; i < 8 * MP; i += gridDim.x * 512) z[i] = 0.f;
        float* rope = (float*)(p.ws + OFF_ROPE);
        for (int i = blockIdx.x * 512 + tid; i < TSEQ * 8; i += gridDim.x * 512) {
            const int t = i >> 3, j = i & 7;
            const float invf[8] = {1.0f, 0.1939227432012558f, 0.03760603070259094f, 0.007292664609849453f, 0.0014142135623842478f,
                                   0.00027424818836152554f, 5.3182957344688475e-05f, 1.0313385246263351e-05f};
            float f = 1.0f;
#pragma unroll
            for (int q = 0; q < 8; ++q) f = (j == q) ? invf[q] : f;
            const float ang = (float)t * f;
            const float kk = rintf(ang * 0.15915494309189535f);
            float r = fmaf(-kk, 6.28125f, ang);
            r = fmaf(-kk, 1.9353071795864769e-3f, r);
            rope[t * 16 + j] = __cosf(r);
            rope[t * 16 + 8 + j] = __sinf(r);
        }
    }
    {
        float* wg = (float*)smem;
        __syncthreads();
        for (int i = tid; i < 8192; i += 512) { const int k = i >> 3, j = i & 7; wg[i] = p.ab_w_in[(size_t)k * 6152 + 4096 + j] * p.norm_mix[k]; }
        __syncthreads();
        bf16_t* hn = (bf16_t*)(p.ws + OFF_HB);
        float* LI = (float*)(p.ws + OFF_LI); float* LF = (float*)(p.ws + OFF_LF);
        const int rstep = gridDim.x * 8;
        int r = blockIdx.x * 8 + wid;
        f32x4 nx[4];
        auto load_row = [&](int rr) __attribute__((always_inline)) {
            const float* s = rr < MR ? p.x + (size_t)rr * 1024 : p.meta + (size_t)(rr - MR) * 1024;
#pragma unroll
            for (int i = 0; i < 4; ++i) nx[i] = *(const f32x4*)(s + i * 256 + lane * 4);
        };
        if (r < MR + 16) load_row(r);
        for (; r < MR + 16; r += rstep) {
            f32x4 v[4];
#pragma unroll
            for (int i = 0; i < 4; ++i) v[i] = nx[i];
            if (r + rstep < MR + 16) load_row(r + rstep);
            float sq = 0.f;
#pragma unroll
            for (int i = 0; i < 4; ++i) sq += v[i][0] * v[i][0] + v[i][1] * v[i][1] + v[i][2] * v[i][2] + v[i][3] * v[i][3];
            float g[8];
#pragma unroll
            for (int j = 0; j < 8; ++j) g[j] = 0.f;
#pragma unroll
            for (int i = 0; i < 4; ++i) {
#pragma unroll
                for (int e = 0; e < 4; ++e) {
                    const float* wr_ = wg + (i * 256 + lane * 4 + e) * 8;
                    const f32x4 w0 = *(const f32x4*)wr_, w1 = *(const f32x4*)(wr_ + 4);
                    g[0] += v[i][e] * w0[0]; g[1] += v[i][e] * w0[1]; g[2] += v[i][e] * w0[2]; g[3] += v[i][e] * w0[3];
                    g[4] += v[i][e] * w1[0]; g[5] += v[i][e] * w1[1]; g[6] += v[i][e] * w1[2]; g[7] += v[i][e] * w1[3];
                }
            }
            sq = wave_sum(sq);
            const float rstd = rsqrtf(sq * (1.0f / 1024.0f) + EPS);
#pragma unroll
            for (int i = 0; i < 4; ++i) {
                u32x2 w; w.x = pk2(v[i][0] * rstd, v[i][1] * rstd); w.y = pk2(v[i][2] * rstd, v[i][3] * rstd);
                *(u32x2*)(hn + (size_t)r * 1024 + i * 256 + lane * 4) = w;
            }
            float h4[4], h2[2], h1;
            {
                const bool up = (lane & 32) != 0;
#pragma unroll
                for (int j = 0; j < 4; ++j) { const float mine = up ? g[4 + j] : g[j], send = up ? g[j] : g[4 + j]; h4[j] = mine + __shfl_xor(send, 32); }
            }
            {
                const bool up = (lane & 16) != 0;
#pragma unroll
                for (int j = 0; j < 2; ++j) { const float mine = up ? h4[2 + j] : h4[j], send = up ? h4[j] : h4[2 + j]; h2[j] = mine + __shfl_xor(send, 16); }
            }
            {
                const bool up = (lane & 8) != 0;
                const float mine = up ? h2[1] : h2[0], send = up ? h2[0] : h2[1];
                h1 = mine + __shfl_xor(send, 8);
            }
            h1 += __shfl_xor(h1, 4); h1 += __shfl_xor(h1, 2); h1 += __shfl_xor(h1, 1);
            if ((lane & 7) == 0) {
                const int gi = ((lane >> 5) & 1) * 4 + ((lane >> 4) & 1) * 2 + ((lane >> 3) & 1);
                const float pre = h1 * rstd + p.ab_if_bias[gi];
                if (gi < 4) LI[r * 4 + gi] = pre;
                else LF[r * 4 + gi - 4] = fminf(pre, 0.f) - log1pf(__expf(-fabsf(pre)));
            }
        }
    }
}

DI f32x4 mfma16(bf16x8 a, bf16x8 b, f32x4 c) { return __builtin_amdgcn_mfma_f32_16x16x32_bf16(a, b, c, 0, 0, 0); }
DI f32x16 mfma32(bf16x8 a, bf16x8 b, f32x16 c) { return __builtin_amdgcn_mfma_f32_32x32x16_bf16(a, b, c, 0, 0, 0); }

DI void mlstm_unit(const Params& p, unsigned char* smem, int unit) {
    const int tid = tid_fresh(), lane = tid & 63, wid = tid >> 6, fr = lane & 15, fq = lane >> 4;
    const int b = unit >> 4, h = (unit >> 2) & 3, sl = unit & 3;
    bf16_t* sQ = (bf16_t*)smem;
    bf16_t* sK = sQ + 64 * 264;
    bf16_t* sCb = sK + 64 * 264;
    bf16_t* sKwt = sCb + 64 * 264;
    bf16_t* sVt = sKwt + 256 * 72;
    bf16_t* sSd = sVt + 64 * 72;
    float* sN = (float*)(sSd + 64 * 72);
    float* gbuf = sN + 256;
    float* snq = gbuf + 2 * 336; float* srs = snq + 64;
    const bf16_t* T1 = (const bf16_t*)(p.ws + OFF_R2);
    bf16_t* OG = (bf16_t*)(p.ws + OFF_R3);
    const float* LI = (const float*)(p.ws + OFF_LI); const float* LF = (const float*)(p.ws + OFF_LF);
    float* HSS = (float*)(p.ws + OFF_HSS);

    f32x4 accC[2][4];
#pragma unroll
    for (int a = 0; a < 2; ++a)
#pragma unroll
        for (int v = 0; v < 4; ++v) accC[a][v] = (f32x4){0.f, 0.f, 0.f, 0.f};
    if (tid < 256) sN[tid] = 0.f;
    float m_prev = 0.f;
    const int ti = wid >> 1, pi = (wid & 1) * 2;

    u32x4 rq[4], rk[4], rv; float rli = 0.f, rlf = 0.f; u32x2 rog[2];
    auto issue_loads = [&](int c) __attribute__((always_inline)) {
        const int base = c == 0 ? MR : b * 4096 + (c - 1) * 64;
        const int nv = c == 0 ? 16 : 64;
#pragma unroll
        for (int i = 0; i < 4; ++i) {
            const int vid = tid + 512 * i, s = vid >> 5, kv = vid & 31;
            const size_t row = (size_t)(base + (s < nv ? s : nv - 1));
            rq[i] = *(const u32x4*)(T1 + row * 4096 + h * 256 + kv * 8);
            rk[i] = *(const u32x4*)(T1 + row * 4096 + 1024 + h * 256 + kv * 8);
        }
        {
            const int s = lane, vv = wid;
            const size_t row = (size_t)(base + (s < nv ? s : nv - 1));
            rv = *(const u32x4*)(T1 + row * 4096 + 2048 + h * 256 + sl * 64 + vv * 8);
        }
        if (wid == 0) {
            const bool ok = lane < nv;
            const int row = base + (ok ? lane : 0);
            rli = ok ? LI[row * 4 + h] : -1e30f;
            rlf = ok ? LF[row * 4 + h] : 0.f;
        }
        {
            const int t = ti * 16 + fr;
            const size_t row = (size_t)(base + (t < nv ? t : 0));
#pragma unroll
            for (int x = 0; x < 2; ++x) rog[x] = *(const u32x2*)(OG + row * 2048 + h * 256 + sl * 64 + (pi + x) * 16 + fq * 4);
        }
    };
    auto gate_scan = [&](float* gb) __attribute__((always_inline)) {
        const float bb = wave_scan_add(rlf);
        const float g = rli - bb;
        const float cm = wave_scan_max(g);
        const float Mt = fmaxf(m_prev, cm);
        const float M63 = __builtin_bit_cast(float, __builtin_amdgcn_readlane(__builtin_bit_cast(int, Mt), 63));
        const float b63 = __builtin_bit_cast(float, __builtin_amdgcn_readlane(__builtin_bit_cast(int, bb), 63));
        gb[lane] = g; gb[64 + lane] = Mt; gb[128 + lane] = __expf(m_prev - Mt); gb[192 + lane] = __expf(-(bb + Mt)); gb[256 + lane] = __expf(g - M63);
        if (lane == 0) gb[320] = __expf(m_prev - M63);
        m_prev = b63 + M63;
    };
    issue_loads(0);
    if (wid == 0) gate_scan(gbuf);
    __syncthreads();

    for (int c = 0; c < 65; ++c) {
        const int base = c == 0 ? MR : b * 4096 + (c - 1) * 64;
        const int nv = c == 0 ? 16 : 64;
        const bool wr_out = c > 0 || b == 0;
        const float* sg = gbuf + (c & 1) * 336; const float* sMt = sg + 64; const float* swp = sg + 128; const float* semt = sg + 192; const float* sws = sg + 256; const float* sdec = sg + 320;
#pragma unroll
        for (int a = 0; a < 2; ++a)
#pragma unroll
            for (int v = 0; v < 4; ++v) {
                u32x2 w; w.x = pk2(accC[a][v][0], accC[a][v][1]); w.y = pk2(accC[a][v][2], accC[a][v][3]);
                *(u32x2*)(sCb + (v * 16 + fr) * 264 + (2 * wid + a) * 16 + fq * 4) = w;
            }
#pragma unroll
        for (int i = 0; i < 4; ++i) {
            const int vid = tid + 512 * i, s = vid >> 5, kv = vid & 31;
            *(u32x4*)(sQ + s * 264 + kv * 8) = rq[i];
            *(u32x4*)(sK + s * 264 + kv * 8) = rk[i];
        }
        {
            const int s = lane, vv = wid;
            const unsigned wv[4] = {rv.x, rv.y, rv.z, rv.w};
#pragma unroll
            for (int e = 0; e < 4; ++e) {
                sVt[(vv * 8 + 2 * e) * 72 + s] = (bf16_t)(wv[e] & 0xffffu);
                sVt[(vv * 8 + 2 * e + 1) * 72 + s] = (bf16_t)(wv[e] >> 16);
            }
        }
        __syncthreads();
        const u32x2 og0 = rog[0], og1 = rog[1];
        if (c + 1 < 65) issue_loads(c + 1);
#pragma unroll
        for (int i = 0; i < 4; ++i) {
            const int task = tid + 512 * i, k = task & 255, s0 = (task >> 8) * 8;
            float v[8];
            const f32x4 wa = *(const f32x4*)(sws + s0), wb = *(const f32x4*)(sws + s0 + 4);
#pragma unroll
            for (int e = 0; e < 4; ++e) { v[e] = bf2f(sK[(s0 + e) * 264 + k]) * wa[e]; v[4 + e] = bf2f(sK[(s0 + 4 + e) * 264 + k]) * wb[e]; }
            u32x4 w; w.x = pk2(v[0], v[1]); w.y = pk2(v[2], v[3]); w.z = pk2(v[4], v[5]); w.w = pk2(v[6], v[7]);
            *(u32x4*)(sKwt + k * 72 + s0) = w;
        }
        f32x4 accH[2];
        {
            bf16x8 Bq[8];
#pragma unroll
            for (int ks = 0; ks < 8; ++ks) Bq[ks] = *(const bf16x8*)(sQ + (ti * 16 + fr) * 264 + ks * 32 + fq * 8);
            const int t = ti * 16 + fr;
            const float Mt_t = sMt[t];
#pragma unroll
            for (int x = 0; x < 2; ++x) {
                const int si = pi + x;
                if (si > ti) {
                    if (fq == 0) srs[si * 64 + t] = 0.f;
                    *(u32x2*)(sSd + t * 72 + si * 16 + fq * 4) = (u32x2){0u, 0u};
                    continue;
                }
                f32x4 aS = (f32x4){0.f, 0.f, 0.f, 0.f};
#pragma unroll
                for (int ks = 0; ks < 8; ++ks) aS = mfma16(*(const bf16x8*)(sK + (si * 16 + fr) * 264 + ks * 32 + fq * 8), Bq[ks], aS);
                float val[4]; float ps = 0.f;
                const f32x4 gv = *(const f32x4*)(sg + si * 16 + fq * 4);
#pragma unroll
                for (int j = 0; j < 4; ++j) {
                    const int s = si * 16 + fq * 4 + j;
                    const float e = __expf(fminf(gv[j] - Mt_t, 0.f));
                    const float d = (s <= t) ? e : 0.f;
                    val[j] = aS[j] * d; ps += val[j];
                }
                ps = sum_x16_x32(ps);
                if (fq == 0) srs[si * 64 + t] = ps;
                u32x2 w; w.x = pk2(val[0], val[1]); w.y = pk2(val[2], val[3]);
                *(u32x2*)(sSd + t * 72 + si * 16 + fq * 4) = w;
            }
#pragma unroll
            for (int x = 0; x < 2; ++x) {
                const int vi = pi + x;
                f32x4 aH = (f32x4){0.f, 0.f, 0.f, 0.f};
#pragma unroll
                for (int ks = 0; ks < 8; ++ks) aH = mfma16(*(const bf16x8*)(sCb + (vi * 16 + fr) * 264 + ks * 32 + fq * 8), Bq[ks], aH);
                accH[x] = aH;
            }
        }
        {
            const int t = tid >> 3, part = tid & 7;
            float s = 0.f;
#pragma unroll
            for (int i = 0; i < 4; ++i) {
                const u32x4 qv = *(const u32x4*)(sQ + t * 264 + part * 32 + i * 8);
                const f32x4 na = *(const f32x4*)(sN + part * 32 + i * 8), nb = *(const f32x4*)(sN + part * 32 + i * 8 + 4);
                s += bflo(qv.x) * na[0] + bfhi(qv.x) * na[1] + bflo(qv.y) * na[2] + bfhi(qv.y) * na[3]
                   + bflo(qv.z) * nb[0] + bfhi(qv.z) * nb[1] + bflo(qv.w) * nb[2] + bfhi(qv.w) * nb[3];
            }
            s += __shfl_xor(s, 1); s += __shfl_xor(s, 2); s += __shfl_xor(s, 4);
            if (part == 0) snq[t] = s;
        }
        __syncthreads();
        {
            const int t = ti * 16 + fr;
            const float wp = swp[t];
            const float den = wp * snq[t] + (srs[t] + srs[64 + t]) + (srs[128 + t] + srs[192 + t]);
            const float inv = __builtin_amdgcn_rcpf(fmaxf(fabsf(den), semt[t]));
            const bool ok = t < nv && wr_out;
            const size_t row = (size_t)(base + (ok ? t : 0));
            float sq = 0.f;
#pragma unroll
            for (int x = 0; x < 2; ++x) {
                const int vi = pi + x;
                f32x4 a = accH[x] * wp;
#pragma unroll
                for (int k2 = 0; k2 < 2; ++k2)
                    a = mfma16(*(const bf16x8*)(sVt + (vi * 16 + fr) * 72 + k2 * 32 + fq * 8), *(const bf16x8*)(sSd + t * 72 + k2 * 32 + fq * 8), a);
                bf16_t* op = OG + row * 2048 + h * 256 + sl * 64 + vi * 16 + fq * 4;
                if (ok) {
                    const u32x2 ov = x == 0 ? og0 : og1;
                    const float h0 = a[0] * inv * bflo(ov.x), h1 = a[1] * inv * bfhi(ov.x), h2 = a[2] * inv * bflo(ov.y), h3 = a[3] * inv * bfhi(ov.y);
                    u32x2 w; w.x = pk2(h0, h1); w.y = pk2(h2, h3);
                    *(u32x2*)op = w;
                    sq += h0 * h0 + h1 * h1 + h2 * h2 + h3 * h3;
                }
            }
            sq = sum_x16_x32(sq);
            if (fq == 0 && ok) atomicAdd(HSS + row * 4 + h, sq);
        }
        {
            const float dec = sdec[0];
            bf16x8 Bv[4][2];
#pragma unroll
            for (int v = 0; v < 4; ++v)
#pragma unroll
                for (int k2 = 0; k2 < 2; ++k2) Bv[v][k2] = *(const bf16x8*)(sVt + (v * 16 + fr) * 72 + k2 * 32 + fq * 8);
#pragma unroll
            for (int a = 0; a < 2; ++a) {
                bf16x8 Ak[2];
#pragma unroll
                for (int k2 = 0; k2 < 2; ++k2) Ak[k2] = *(const bf16x8*)(sKwt + ((2 * wid + a) * 16 + fr) * 72 + k2 * 32 + fq * 8);
#pragma unroll
                for (int v = 0; v < 4; ++v) {
                    f32x4 acc = accC[a][v] * dec;
                    acc = mfma16(Ak[0], Bv[v][0], acc);
                    acc = mfma16(Ak[1], Bv[v][1], acc);
                    accC[a][v] = acc;
                }
            }
            if (tid < 256) {
                float s = 0.f;
#pragma unroll
                for (int i = 0; i < 8; ++i) {
                    const u32x4 kv = *(const u32x4*)(sKwt + tid * 72 + i * 8);
                    s += (bflo(kv.x) + bfhi(kv.x)) + (bflo(kv.y) + bfhi(kv.y)) + (bflo(kv.z) + bfhi(kv.z)) + (bflo(kv.w) + bfhi(kv.w));
                }
                sN[tid] = dec * sN[tid] + s;
            }
        }
        if (wid == 0 && c + 1 < 65) gate_scan(gbuf + ((c + 1) & 1) * 336);
        __syncthreads();
    }
}

DI void lru_unit(const Params& p, unsigned char* smem, int unit) {
    const int tid = tid_fresh(), lane = tid & 63, wid = tid >> 6, fr = lane & 15, fq = lane >> 4;
    const int b = unit >> 4, n = (unit >> 1) & 7, half = unit & 1;
    bf16_t* sW = (bf16_t*)smem;
    bf16_t* sRaw = sW + 128 * 136;
    bf16_t* sXc = sRaw + 68 * 128;
    float* sXf = (float*)(sXc + 64 * 136);
    float* sA = sXf + 64 * 64;
    float* sU = sA + 64 * 65;
    const bf16_t* T1 = (const bf16_t*)(p.ws + OFF_R2);
    bf16_t* OG = (bf16_t*)(p.ws + OFF_R3);
    const bf16_t* WL = (const bf16_t*)(p.ws + OFF_WLRU);
#pragma unroll
    for (int i = 0; i < 4; ++i) {
        const int vid = tid + 512 * i, rr = vid >> 4, part = vid & 15;
        const int which = rr >> 6, e = half * 64 + (rr & 63);
        *(u32x4*)(sW + rr * 136 + part * 8) = *(const u32x4*)(WL + ((size_t)((n * 2 + which) * 128 + e)) * 128 + part * 8);
    }
    const int d8 = tid & 15, tq = tid >> 4;
    float cw[4][8], cb[8];
#pragma unroll
    for (int e = 0; e < 8; ++e) {
        const int ch = n * 128 + d8 * 8 + e;
        cb[e] = p.conv_b[ch];
#pragma unroll
        for (int j = 0; j < 4; ++j) cw[j][e] = p.conv_w[j * 1024 + ch];
    }
    const int et = wid & 3;
    float br[4], bi[4], sp[4];
#pragma unroll
    for (int j = 0; j < 4; ++j) {
        const int ch = n * 128 + half * 64 + et * 16 + fq * 4 + j;
        br[j] = p.b_r[ch]; bi[j] = p.b_i[ch];
        const float l = p.lam[ch];
        sp[j] = fmaxf(-l, 0.f) + log1pf(__expf(-fabsf(l)));
    }
    float hstate = 0.f;

    u32x4 rr_[3], rg_;
    auto issue_loads = [&](int c) __attribute__((always_inline)) {
        const int t0 = c == 0 ? 0 : 16 + (c - 1) * 64;
        {
            const int t = tid >> 3, nvc = c == 0 ? 16 : 64;
            const size_t row = (size_t)((c == 0 ? MR : b * 4096 + (c - 1) * 64) + (t < nvc ? t : 0));
            rg_ = *(const u32x4*)(OG + row * 2048 + 1024 + n * 128 + half * 64 + (tid & 7) * 8);
        }
#pragma unroll
        for (int i = 0; i < 3; ++i) {
            const int vid = tid + 512 * i, ri = vid >> 4, part = vid & 15;
            const int tt = t0 - 3 + ri;
            u32x4 v = (u32x4){0u, 0u, 0u, 0u};
            if (ri < 67 && tt >= 0 && tt < TSEQ) {
                const size_t row = tt < 16 ? (size_t)(MR + tt) : (size_t)(b * 4096 + tt - 16);
                v = *(const u32x4*)(T1 + row * 4096 + 3072 + n * 128 + part * 8);
            }
            rr_[i] = v;
        }
    };
    issue_loads(0);
    __syncthreads();
    for (int c = 0; c < 65; ++c) {
        const int base = c == 0 ? MR : b * 4096 + (c - 1) * 64;
        const int nv = c == 0 ? 16 : 64;
#pragma unroll
        for (int i = 0; i < 3; ++i) {
            const int vid = tid + 512 * i, ri = vid >> 4, part = vid & 15;
            if (ri < 67) *(u32x4*)(sRaw + ri * 128 + part * 8) = rr_[i];
        }
        __syncthreads();
        const u32x4 gv = rg_;
        if (c + 1 < 65) issue_loads(c + 1);
        {
            float x[5][8];
#pragma unroll
            for (int r = 0; r < 5; ++r) {
                const u32x4 v = *(const u32x4*)(sRaw + (2 * tq + r) * 128 + d8 * 8);
                x[r][0] = bflo(v.x); x[r][1] = bfhi(v.x); x[r][2] = bflo(v.y); x[r][3] = bfhi(v.y);
                x[r][4] = bflo(v.z); x[r][5] = bfhi(v.z); x[r][6] = bflo(v.w); x[r][7] = bfhi(v.w);
            }
#pragma unroll
            for (int tt = 0; tt < 2; ++tt) {
                const int t = 2 * tq + tt;
                float o[8];
#pragma unroll
                for (int e = 0; e < 8; ++e) o[e] = cb[e] + cw[0][e] * x[tt][e] + cw[1][e] * x[tt + 1][e] + cw[2][e] * x[tt + 2][e] + cw[3][e] * x[tt + 3][e];
                u32x4 w; w.x = pk2(o[0], o[1]); w.y = pk2(o[2], o[3]); w.z = pk2(o[4], o[5]); w.w = pk2(o[6], o[7]);
                *(u32x4*)(sXc + t * 136 + d8 * 8) = w;
                if ((d8 >> 3) == half) {
                    float* xf = sXf + t * 64 + (d8 & 7) * 8;
                    *(f32x4*)xf = (f32x4){o[0], o[1], o[2], o[3]};
                    *(f32x4*)(xf + 4) = (f32x4){o[4], o[5], o[6], o[7]};
                }
            }
        }
        __syncthreads();
        {
            bf16x8 Ar[4], Ai[4];
#pragma unroll
            for (int ks = 0; ks < 4; ++ks) {
                Ar[ks] = *(const bf16x8*)(sW + (et * 16 + fr) * 136 + ks * 32 + fq * 8);
                Ai[ks] = *(const bf16x8*)(sW + (64 + et * 16 + fr) * 136 + ks * 32 + fq * 8);
            }
#pragma unroll
            for (int x = 0; x < 2; ++x) {
                const int t = ((wid >> 2) * 2 + x) * 16 + fr;
                f32x4 aR = (f32x4){0.f, 0.f, 0.f, 0.f}, aI = (f32x4){0.f, 0.f, 0.f, 0.f};
#pragma unroll
                for (int ks = 0; ks < 4; ++ks) {
                    const bf16x8 Bx = *(const bf16x8*)(sXc + t * 136 + ks * 32 + fq * 8);
                    aR = mfma16(Ar[ks], Bx, aR);
                    aI = mfma16(Ai[ks], Bx, aI);
                }
                const f32x4 xv = *(const f32x4*)(sXf + t * 64 + et * 16 + fq * 4);
#pragma unroll
                for (int j = 0; j < 4; ++j) {
                    const float r = sigmoidf_(aR[j] + br[j]), ig = sigmoidf_(aI[j] + bi[j]);
                    const float la = -8.0f * r * sp[j];
                    const float a = __expf(la);
                    const float u = sqrtf(fmaxf(-expm1f(2.0f * la), 0.f)) * (ig * xv[j]);
                    sA[t * 65 + et * 16 + fq * 4 + j] = a;
                    sU[t * 65 + et * 16 + fq * 4 + j] = u;
                }
            }
        }
        __syncthreads();
        if (wid == 0) {
            float hs = hstate;
            for (int t0 = 0; t0 < nv; t0 += 16) {
                float av[16], uv[16];
#pragma unroll
                for (int i = 0; i < 16; ++i) { av[i] = sA[(t0 + i) * 65 + lane]; uv[i] = sU[(t0 + i) * 65 + lane]; }
#pragma unroll
                for (int i = 0; i < 16; ++i) { hs = av[i] * hs + uv[i]; uv[i] = hs; }
#pragma unroll
                for (int i = 0; i < 16; ++i) sU[(t0 + i) * 65 + lane] = uv[i];
            }
            hstate = hs;
        }
        __syncthreads();
        {
            const int t = tid >> 3, e0 = (tid & 7) * 8;
            if (t < nv && (c > 0 || b == 0)) {
                bf16_t* op = OG + (size_t)(base + t) * 2048 + 1024 + n * 128 + half * 64 + e0;
                const float* hp = sU + t * 65 + e0;
                u32x4 w;
                w.x = pk2(hp[0] * bflo(gv.x), hp[1] * bfhi(gv.x)); w.y = pk2(hp[2] * bflo(gv.y), hp[3] * bfhi(gv.y));
                w.z = pk2(hp[4] * bflo(gv.z), hp[5] * bfhi(gv.z)); w.w = pk2(hp[6] * bflo(gv.w), hp[7] * bfhi(gv.w));
                *(u32x4*)op = w;
            }
        }
    }
    __syncthreads();
}

DI void mixer0_phase(const Params& p, unsigned char* smem, int mask = 3, bool conv = true) {
    for (int w = blockIdx.x; w < 256; w += gridDim.x) {
        if (w < 128) { if (mask & 1) mlstm_unit(p, smem, w); } else { if (mask & 2) lru_unit(p, smem, w - 128); }
        __syncthreads();
    }
    const int half = gridDim.x >> 1;
    if (conv && (int)blockIdx.x >= half) wt_convert(p, smem, 1, 8, blockIdx.x - half, gridDim.x - half);
}

DI void headnorm_phase(const Params& p) {
    const int tid = tid_fresh(), lane = tid & 63, wid = tid >> 6;
    bf16_t* OG = (bf16_t*)(p.ws + OFF_R3);
    const float* HSS = (const float*)(p.ws + OFF_HSS);
    for (int r = blockIdx.x * 8 + wid; r < MR + 16; r += gridDim.x * 8) {
        const float sc = rsqrtf(HSS[r * 4 + (lane >> 4)] * (1.0f / 256.0f) + EPS);
        bf16_t* op = OG + (size_t)r * 2048 + lane * 16;
#pragma unroll
        for (int i = 0; i < 2; ++i) {
            const u32x4 v = *(const u32x4*)(op + i * 8);
            u32x4 w;
            w.x = pk2(bflo(v.x) * sc, bfhi(v.x) * sc); w.y = pk2(bflo(v.y) * sc, bfhi(v.y) * sc);
            w.z = pk2(bflo(v.z) * sc, bfhi(v.z) * sc); w.w = pk2(bflo(v.w) * sc, bfhi(v.w) * sc);
            *(u32x4*)(op + i * 8) = w;
        }
    }
}

DI bf16x8 pack8(const f32x16& x, int s) {
    u32x4 w; w.x = pk2(x[8 * s], x[8 * s + 1]); w.y = pk2(x[8 * s + 2], x[8 * s + 3]); w.z = pk2(x[8 * s + 4], x[8 * s + 5]); w.w = pk2(x[8 * s + 6], x[8 * s + 7]);
    return __builtin_bit_cast(bf16x8, w);
}
DI void attn_phase(const Params& p, unsigned char* smem) {
    const int tid = tid_fresh(), lane = tid & 63, wid = tid >> 6, l31 = lane & 31, hi = lane >> 5;
    const int comp = wid & 1, qg = wid >> 1;
    LAS unsigned char* lds = (LAS unsigned char*)smem;
    bf16_t* sK = (bf16_t*)smem;
    bf16_t* sV = sK + 2 * 64 * 128;
    float* sO = (float*)smem;
    const bf16_t* QK = (const bf16_t*)(p.ws + OFF_QK1);
    const bf16_t* VT = (const bf16_t*)(p.ws + OFF_VT);
    bf16_t* AO = (bf16_t*)(p.ws + OFF_AO);
    const float lam = __builtin_bit_cast(float, __builtin_amdgcn_readfirstlane(((const int*)(p.ws + OFF_MISC))[0]));
    const int wu = __builtin_amdgcn_readfirstlane(wid);
    for (int unit = blockIdx.x; unit < 2048; unit += gridDim.x) {
        const int round = unit >> 8, i256 = unit & 255, bh = i256 >> 2, jj = i256 & 3;
        const int qb = (round & 1) ? 24 - 8 * (round >> 1) + jj : 31 - 8 * (round >> 1) - jj;
        const int b = bh >> 3, head = bh & 7;
        const int q0 = qb * 128 + qg * 32;
        bf16x8 Qf[4];
#pragma unroll
        for (int ks = 0; ks < 4; ++ks) Qf[ks] = *(const bf16x8*)(QK + (size_t)(b * 4096 + q0 + l31) * 2048 + head * 128 + comp * 64 + ks * 16 + hi * 8);
        f32x16 O[4];
#pragma unroll
        for (int d = 0; d < 4; ++d)
#pragma unroll
            for (int i = 0; i < 16; ++i) O[d][i] = 0.f;
        float mrun = -INFINITY, lrun = 0.f;
        const int ntile = 2 * (qb + 1) + 1;

        auto dma_tile = [&](int j, int buf) __attribute__((always_inline)) {
            const size_t krow0 = j == 0 ? (size_t)MR : (size_t)(b * 4096 + (j - 1) * 64);
#pragma unroll
            for (int i = 0; i < 2; ++i) {
                const int bi = wu * 2 + i;
                {
                    const int key = 4 * bi + (lane >> 4), part = (lane & 15) ^ (key & 15);
                    __builtin_amdgcn_global_load_lds((const unsigned*)(QK + (krow0 + key) * 2048 + 1024 + head * 128 + part * 8),
                                                     (LAS unsigned*)(lds + buf * 16384 + bi * 1024), 16, 0, 0);
                }
                {
                    const int dv = 8 * bi + (lane >> 3), ch = (lane & 7) ^ ((dv >> 1) & 7);
                    __builtin_amdgcn_global_load_lds((const unsigned*)(VT + (size_t)(head * 128 + dv) * MP + krow0 + ch * 8),
                                                     (LAS unsigned*)(lds + 32768 + buf * 16384 + bi * 1024), 16, 0, 0);
                }
            }
        };
        auto qk_half = [&](const bf16_t* kb, int kh, int ksw) __attribute__((always_inline)) {
            f32x16 S;
#pragma unroll
            for (int i = 0; i < 16; ++i) S[i] = 0.f;
#pragma unroll
            for (int ks = 0; ks < 4; ++ks)
                S = mfma32(*(const bf16x8*)(kb + (kh * 32 + l31) * 128 + (((comp * 8 + ks * 2 + hi) ^ ksw) * 8)), Qf[ks], S);
            return S;
        };
        auto softmax_half = [&](f32x16& S, int j, int kh, int kbase, bool need_mask, bf16x8 (&P)[2]) __attribute__((always_inline)) {
            if (need_mask) {
#pragma unroll
                for (int i = 0; i < 16; ++i) {
                    const int key = kh * 32 + 8 * (i >> 2) + 4 * hi + (i & 3);
                    const bool vis = (j == 0) ? (key < 16) : (kbase + key <= q0 + l31);
                    if (!vis) S[i] = -INFINITY;
                }
            }
            float mx = S[0];
#pragma unroll
            for (int i = 1; i < 16; ++i) mx = fmaxf(mx, S[i]);
            mx = max_x32(mx);
            if (__any(mx > mrun + 8.0f)) {
                const float mn = fmaxf(mrun, mx);
                const float alpha = __builtin_amdgcn_exp2f(mrun - mn);
                mrun = mn;
                lrun *= alpha;
#pragma unroll
                for (int d = 0; d < 4; ++d) O[d] = O[d] * alpha;
            }
            float ls = 0.f;
#pragma unroll
            for (int i = 0; i < 16; ++i) { const float e = __builtin_amdgcn_exp2f(S[i] - mrun); S[i] = e; ls += e; }
            lrun += ls;
            P[0] = pack8(S, 0); P[1] = pack8(S, 1);
        };
        auto pv_half = [&](const bf16_t* vb, int kh, int dsw, const bf16x8 (&P)[2]) __attribute__((always_inline)) {
#pragma unroll
            for (int s2 = 0; s2 < 2; ++s2) {
                const int u = kh * 2 + s2;
#pragma unroll
                for (int d = 0; d < 4; ++d) {
                    const bf16x8 A = *(const bf16x8*)(vb + (d * 32 + l31) * 64 + (((2 * u + hi) ^ dsw) * 8));
                    O[d] = mfma32(A, P[s2], O[d]);
                }
            }
        };

        __syncthreads();
        dma_tile(0, 0);
        asm volatile("s_waitcnt vmcnt(0)" ::: "memory");
        __syncthreads();
        for (int j = 0; j < ntile; ++j) {
            const int buf = j & 1;
            if (j + 1 < ntile) dma_tile(j + 1, buf ^ 1);
            const int kbase = (j - 1) * 64;
            const bool active = (j == 0) || (kbase <= q0 + 31);
            if (active) {
                const bf16_t* kb = sK + buf * 64 * 128;
                const bf16_t* vb = sV + buf * 128 * 64;
                const bool need_mask = (j == 0) || (kbase + 63 > q0);
                const bool act1 = (j >= 1) && (kbase + 32 <= q0 + 31);
                const int ksw = l31 & 15, dsw = (l31 >> 1) & 7;
                f32x16 S0 = qk_half(kb, 0, ksw);
                bf16x8 P[2];
                if (act1) {
                    f32x16 S1 = qk_half(kb, 1, ksw);
                    softmax_half(S0, j, 0, kbase, need_mask, P);
                    pv_half(vb, 0, dsw, P);
                    softmax_half(S1, j, 1, kbase, need_mask, P);
                    pv_half(vb, 1, dsw, P);
                } else {
                    softmax_half(S0, j, 0, kbase, need_mask, P);
                    pv_half(vb, 0, dsw, P);
                }
            }
            asm volatile("s_waitcnt vmcnt(0)" ::: "memory");
            __syncthreads();
        }
        {
            const float l = sum_x32(lrun);
            float* so = sO + qg * 4096 + lane;
            if (comp == 1) {
                const float sc1 = lam / l;
#pragma unroll
                for (int d = 0; d < 4; ++d)
#pragma unroll
                    for (int i = 0; i < 16; ++i) so[(d * 16 + i) * 64] = O[d][i] * sc1;
            }
            __syncthreads();
            if (comp == 0) {
                const float i0 = 1.0f / l;
                float sq = 0.f;
#pragma unroll
                for (int d = 0; d < 4; ++d)
#pragma unroll
                    for (int i = 0; i < 16; ++i) { const float o = O[d][i] * i0 - so[(d * 16 + i) * 64]; O[d][i] = o; sq += o * o; }
                sq = sum_x32(sq);
                const float sc = rsqrtf(sq * (1.0f / 128.0f) + EPS);
                bf16_t* op = AO + (size_t)(b * 4096 + q0 + l31) * 1024 + head * 128;
#pragma unroll
                for (int d = 0; d < 4; ++d)
#pragma unroll
                    for (int g = 0; g < 4; ++g) {
                        u32x2 w; w.x = pk2(O[d][4 * g] * sc, O[d][4 * g + 1] * sc); w.y = pk2(O[d][4 * g + 2] * sc, O[d][4 * g + 3] * sc);
                        *(u32x2*)(op + d * 32 + 8 * g + 4 * hi) = w;
                    }
            }
        }
    }
}

DI void final_phase(const Params& p) {
    const int tid = tid_fresh(), lane = tid & 63, wid = tid >> 6;
    const float* h = (const float*)(p.ws + OFF_H);
    const float* ss = (const float*)(p.ws + OFF_SS) + 3 * MP;
    for (int r = blockIdx.x * 8 + wid; r < MR; r += gridDim.x * 8) {
        const float rstd = rsqrtf(ss[r] * (1.0f / 1024.0f) + EPS);
#pragma unroll
        for (int i = 0; i < 4; ++i) {
            const int c = i * 256 + lane * 4;
            const f32x4 v = *(const f32x4*)(h + (size_t)r * 1024 + c);
            const f32x4 g = *(const f32x4*)(p.norm_final + c);
            *(f32x4*)(p.out + (size_t)r * 1024 + c) = v * rstd * g;
        }
    }
}

template <class Epi> DI void small_gemm(const bf16_t* A, const bf16_t* Bt, int N, int K, const Epi& E) {
    const int tid = tid_fresh(), lane = tid & 63, wid = tid >> 6, fr = lane & 15, fq = lane >> 4;
    const int nw = gridDim.x * 8;
    for (int tile = blockIdx.x * 8 + wid; tile < (N >> 4); tile += nw) {
        const int n0 = tile * 16;
        f32x4 acc = (f32x4){0.f, 0.f, 0.f, 0.f};
        const bf16_t* ap = A + (size_t)fr * K + fq * 8;
        const bf16_t* bp = Bt + (size_t)(n0 + fr) * K + fq * 8;
#pragma unroll 16
        for (int k = 0; k < K; k += 32) acc = mfma16(*(const bf16x8*)(bp + k), *(const bf16x8*)(ap + k), acc);
        E(acc, fr, n0 + fq * 4, fq);
    }
}
struct SEpiIn0 {
    bf16_t* T1; bf16_t* OG;
    DI void operator()(f32x4 v, int row, int n, int fq) const {
        bf16_t* dst;
        if (n < 4096) dst = T1 + (size_t)(MR + row) * 4096 + n;
        else {
            dst = OG + (size_t)(MR + row) * 2048 + (n - 4096);
            if (n < 5120) {
#pragma unroll
                for (int j = 0; j < 4; ++j) v[j] = sigmoidf_(v[j]);
            } else {
#pragma unroll
                for (int j = 0; j < 4; ++j) v[j] = gelu_tanh(v[j]);
            }
        }
        u32x2 w; w.x = pk2(v[0], v[1]); w.y = pk2(v[2], v[3]);
        *(u32x2*)dst = w;
    }
};
template <int MODE> struct SEpiRes {
    float* h; bf16_t* hb; float* ss; const float* meta;
    DI void operator()(f32x4 acc, int row, int n, int fq) const {
        const size_t r = (size_t)(MR + row);
        const f32x4 rv = MODE == 0 ? *(const f32x4*)(meta + (size_t)row * 1024 + n) : *(const f32x4*)(h + r * 1024 + n);
        const f32x4 v = acc + rv;
        *(f32x4*)(h + r * 1024 + n) = v;
        u32x2 w; w.x = pk2(v[0], v[1]); w.y = pk2(v[2], v[3]);
        *(u32x2*)(hb + r * 1024 + n) = w;
        float sq = v[0] * v[0] + v[1] * v[1] + v[2] * v[2] + v[3] * v[3];
        sq = sum_x16_x32(sq);
        if (fq == 0) atomicAdd(ss + r, sq);
    }
};
struct SEpiUp {
    bf16_t* HID; const float* ss;
    DI void operator()(f32x4 v, int row, int n, int fq) const {
        const size_t r = (size_t)(MR + row);
        const float rstd = rsqrtf(ss[r] * (1.0f / 1024.0f) + EPS);
#pragma unroll
        for (int j = 0; j < 4; ++j) { const float a = fmaxf(v[j] * rstd, 0.f); v[j] = a * a; }
        u32x2 w; w.x = pk2(v[0], v[1]); w.y = pk2(v[2], v[3]);
        *(u32x2*)(HID + r * 4096 + n) = w;
    }
};
struct SEpiQKV {
    bf16_t* QK; bf16_t* VT; const float* ss; const float* rope;
    DI void operator()(f32x4 v, int row, int n, int fq) const {
        const size_t r = (size_t)(MR + row);
        const float rstd = rsqrtf(ss[r] * (1.0f / 1024.0f) + EPS);
#pragma unroll
        for (int j = 0; j < 4; ++j) v[j] *= rstd;
        if (n < 2048) {
            if (((n - fq * 4) & 63) == 0) {
                const f32x4 cs = *(const f32x4*)(rope + row * 16 + (fq & 1) * 4), sn = *(const f32x4*)(rope + row * 16 + 8 + (fq & 1) * 4);
#pragma unroll
                for (int j = 0; j < 4; ++j) {
                    const float other = __shfl_xor(v[j], 32);
                    v[j] = fq < 2 ? v[j] * cs[j] - other * sn[j] : v[j] * cs[j] + other * sn[j];
                }
            }
            u32x2 w; w.x = pk2(v[0], v[1]); w.y = pk2(v[2], v[3]);
            *(u32x2*)(QK + r * 2048 + n) = w;
        } else {
#pragma unroll
            for (int j = 0; j < 4; ++j) VT[(size_t)(n - 2048 + j) * MP + MR + ((row & 3) | ((row & 4) << 1) | ((row & 8) >> 1))] = f2bf(v[j]);
        }
    }
};

#define XB_TMO      128
#define XB_XCNT(j)  (256  + 64 * (j))
#define XB_XSUB(j)  (1280 + 64 * (j))
#define XB_XGEN(j)  (2304 + 64 * (j))
#define XB_TOP      3328
#define XB_TOPGEN   3392
#define XCD_BAR_WORDS 3456
#define XB_SPIN_CAP (1u << 18)
DI unsigned xb_ld(unsigned* p)              { return __hip_atomic_load(p, __ATOMIC_RELAXED, __HIP_MEMORY_SCOPE_AGENT); }
DI unsigned xb_add(unsigned* p, unsigned v) { return __hip_atomic_fetch_add(p, v, __ATOMIC_RELAXED, __HIP_MEMORY_SCOPE_AGENT); }
DI unsigned xb_xcc_id() { return (unsigned)__builtin_amdgcn_s_getreg((3 << 11) | 20) & 0xFu; }
#define XB_SPIN(cond, bar) do { unsigned _sp = 0; while (cond) { __builtin_amdgcn_s_sleep(1); \
    if ((++_sp & 255u) == 0u) { if (xb_ld(&(bar)[XB_TMO])) break; if (_sp > XB_SPIN_CAP) { atomicAdd(&(bar)[XB_TMO], 1u); break; } } } } while (0)
struct XcdBarrier { unsigned* bar; unsigned x; volatile LAS unsigned* st; };
DI XcdBarrier xcd_barrier_post(unsigned* bar, volatile LAS unsigned* st) {
    XcdBarrier b; b.bar = bar; b.x = xb_xcc_id(); b.st = st;
    if (threadIdx.x == 0) (void)xb_add(&bar[XB_XCNT(b.x)], 1u);
    return b;
}
DI void xcd_barrier_complete(unsigned* bar, unsigned x, unsigned& nloc, unsigned& nx) {
    const unsigned G = gridDim.x * gridDim.y * gridDim.z;
    unsigned sum, cnt, mine, sp = 0u;
    for (;;) {
        sum = 0u; cnt = 0u; mine = 0u;
#pragma unroll
        for (unsigned j = 0; j < 16; ++j) { const unsigned c = xb_ld(&bar[XB_XCNT(j)]); sum += c; cnt += (c > 0u) ? 1u : 0u; mine = (j == x) ? c : mine; }
        if (sum == G) break;
        __builtin_amdgcn_s_sleep(1);
        if ((++sp & 255u) == 0u) { if (xb_ld(&bar[XB_TMO])) break; if (sp > XB_SPIN_CAP) { atomicAdd(&bar[XB_TMO], 1u); break; } }
    }
    nloc = mine > 0u ? mine : 1u; nx = cnt > 0u ? cnt : 1u;
}
DI void xcd_barrier(const XcdBarrier& b) {
    asm volatile("s_waitcnt vmcnt(0)" ::: "memory");
    __syncthreads();
    if (threadIdx.x == 0) {
        unsigned* bar = b.bar;
        __builtin_amdgcn_s_waitcnt(0);
        unsigned nloc = b.st[0], nx = b.st[1];
        if (nloc == 0u) { xcd_barrier_complete(bar, b.x, nloc, nx); b.st[0] = nloc; b.st[1] = nx; }
        const unsigned old = xb_add(&bar[XB_XSUB(b.x)], 1u);
        const unsigned gen = old / nloc;
        if (old + 1u == (gen + 1u) * nloc) {
            __builtin_amdgcn_fence(__ATOMIC_RELEASE, "agent");
            asm volatile("s_waitcnt vmcnt(0)" ::: "memory");
            const unsigned og = xb_add(&bar[XB_TOP], 1u);
            const unsigned tg = og / nx;
            if (og + 1u == (tg + 1u) * nx) xb_add(&bar[XB_TOPGEN], 1u);
            else XB_SPIN(xb_ld(&bar[XB_TOPGEN]) == tg, bar);
            __builtin_amdgcn_fence(__ATOMIC_ACQUIRE, "agent");
            xb_add(&bar[XB_XGEN(b.x)], 1u);
            asm volatile("s_waitcnt vmcnt(0)" ::: "memory");
        } else {
            XB_SPIN(xb_ld(&bar[XB_XGEN(b.x)]) == gen, bar);
            __builtin_amdgcn_fence(__ATOMIC_ACQUIRE, "agent");
            asm volatile("s_waitcnt vmcnt(0)" ::: "memory");
        }
    }
    __syncthreads();
}

#ifndef DUP
#define DUP 0
#endif
__global__ void __launch_bounds__(512) fwd_megakernel(Params p) {
    extern __shared__ __attribute__((aligned(16))) unsigned char smem[];
    cg::grid_group grid = cg::this_grid();
    LAS unsigned char* lds = (LAS unsigned char*)smem;
    const int G = gridDim.x, c = blockIdx.x;
    bf16_t* HB = (bf16_t*)(p.ws + OFF_HB);
    float* H = (float*)(p.ws + OFF_H);
    float* SS = (float*)(p.ws + OFF_SS);
    bf16_t* HID = (bf16_t*)(p.ws + OFF_HID);
    pg8::StaticOrder S;

    unsigned* bar = (unsigned*)(p.ws + OFF_BAR);
    volatile LAS unsigned* xst = (volatile LAS unsigned*)(lds + LDS_BYTES - 16);
    if (threadIdx.x == 0) { xst[0] = 0u; xst[1] = 0u; }
    __syncthreads();
    const XcdBarrier xb = xcd_barrier_post(bar, xst);
    if (p.out == nullptr) grid.sync();
    prologue_phase(p, smem);
    xcd_barrier(xb);
#if DUP == 4
    prologue_phase(p, smem);
    xcd_barrier(xb);
#endif
    {
        pg8::Gemm g{HB, (const bf16_t*)(p.ws + OFF_WIN0), MR, 6144, 1024};
        EpiIn0 E{(bf16_t*)(p.ws + OFF_R2), (bf16_t*)(p.ws + OFF_R3)};
        SEpiIn0 Es{(bf16_t*)(p.ws + OFF_R2), (bf16_t*)(p.ws + OFF_R3)};
        small_gemm(HB + (size_t)MR * 1024, g.Bt, 6144, 1024, Es);
        S.init(MR, 6144, G, c); pg8::gemm_phase(lds, g, S, E);
    }
    xcd_barrier(xb);
    mixer0_phase(p, smem);
    xcd_barrier(xb);
#if DUP == 2
    {
        pg8::Gemm g{HB, (const bf16_t*)(p.ws + OFF_WIN0), MR, 6144, 1024};
        EpiIn0 E{(bf16_t*)(p.ws + OFF_R2), (bf16_t*)(p.ws + OFF_R3)};
        SEpiIn0 Es{(bf16_t*)(p.ws + OFF_R2), (bf16_t*)(p.ws + OFF_R3)};
        small_gemm(HB + (size_t)MR * 1024, g.Bt, 6144, 1024, Es);
        S.init(MR, 6144, G, c); pg8::gemm_phase(lds, g, S, E);
        float* z = (float*)(p.ws + OFF_HSS);
        for (int i = blockIdx.x * 512 + threadIdx.x; i < 4 * MP; i += gridDim.x * 512) z[i] = 0.f;
    }
    xcd_barrier(xb);
    mixer0_phase(p, smem);
    xcd_barrier(xb);
#endif
#if DUP == 6 || DUP == 7
    {
        pg8::Gemm g{HB, (const bf16_t*)(p.ws + OFF_WIN0), MR, 6144, 1024};
        EpiIn0 E{(bf16_t*)(p.ws + OFF_R2), (bf16_t*)(p.ws + OFF_R3)};
        SEpiIn0 Es{(bf16_t*)(p.ws + OFF_R2), (bf16_t*)(p.ws + OFF_R3)};
        small_gemm(HB + (size_t)MR * 1024, g.Bt, 6144, 1024, Es);
        S.init(MR, 6144, G, c); pg8::gemm_phase(lds, g, S, E);
        float* z = (float*)(p.ws + OFF_HSS);
        for (int i = blockIdx.x * 512 + threadIdx.x; i < 4 * MP; i += gridDim.x * 512) z[i] = 0.f;
    }
    xcd_barrier(xb);
    mixer0_phase(p, smem, DUP == 6 ? 1 : 2, false);
    xcd_barrier(xb);
    {
        pg8::Gemm g{HB, (const bf16_t*)(p.ws + OFF_WIN0), MR, 6144, 1024};
        EpiIn0 E{(bf16_t*)(p.ws + OFF_R2), (bf16_t*)(p.ws + OFF_R3)};
        SEpiIn0 Es{(bf16_t*)(p.ws + OFF_R2), (bf16_t*)(p.ws + OFF_R3)};
        small_gemm(HB + (size_t)MR * 1024, g.Bt, 6144, 1024, Es);
        S.init(MR, 6144, G, c); pg8::gemm_phase(lds, g, S, E);
        float* z = (float*)(p.ws + OFF_HSS);
        for (int i = blockIdx.x * 512 + threadIdx.x; i < 4 * MP; i += gridDim.x * 512) z[i] = 0.f;
    }
    xcd_barrier(xb);
    mixer0_phase(p, smem, 3, false);
    xcd_barrier(xb);
#endif
    headnorm_phase(p);
    xcd_barrier(xb);
    {
        pg8::Gemm g{(const bf16_t*)(p.ws + OFF_R3), (const bf16_t*)(p.ws + OFF_WOUT0), MR, 1024, 2048};
        EpiRes<0> E{H, HB, SS + 0 * MP, p.x, p.meta};
        SEpiRes<0> Es{H, HB, SS + 0 * MP, p.meta};
        small_gemm(g.A + (size_t)MR * 2048, g.Bt, 1024, 2048, Es);
        S.init(MR, 1024, G, c); pg8::gemm_phase(lds, g, S, E);
    }
    xcd_barrier(xb);
    {
        pg8::Gemm g{HB, (const bf16_t*)(p.ws + OFF_WM10), MR, 4096, 1024};
        EpiUp E{HID, SS + 0 * MP};
        SEpiUp Es{HID, SS + 0 * MP};
        small_gemm(HB + (size_t)MR * 1024, g.Bt, 4096, 1024, Es);
        S.init(MR, 4096, G, c); pg8::gemm_phase(lds, g, S, E);
#if DUP == 3
        xcd_barrier(xb);
        S.init(MR, 4096, G, c); pg8::gemm_phase(lds, g, S, E);
#endif
    }
    xcd_barrier(xb);
    {
        pg8::Gemm g{HID, (const bf16_t*)(p.ws + OFF_WM20), MR, 1024, 4096};
        EpiRes<1> E{H, HB, SS + 1 * MP, nullptr, nullptr};
        SEpiRes<1> Es{H, HB, SS + 1 * MP, nullptr};
        small_gemm(HID + (size_t)MR * 4096, g.Bt, 1024, 4096, Es);
        S.init(MR, 1024, G, c); pg8::gemm_phase(lds, g, S, E);
    }
    xcd_barrier(xb);
    {
        pg8::Gemm g{HB, (const bf16_t*)(p.ws + OFF_WIN1), MR, 2048, 1024};
        EpiQK E{(bf16_t*)(p.ws + OFF_QK1), SS + 1 * MP, (const float*)(p.ws + OFF_ROPE)};
        SEpiQKV Es{(bf16_t*)(p.ws + OFF_QK1), (bf16_t*)(p.ws + OFF_VT), SS + 1 * MP, (const float*)(p.ws + OFF_ROPE)};
        small_gemm(HB + (size_t)MR * 1024, g.Bt, 3072, 1024, Es);
        {
            bf16_t* QKz = (bf16_t*)(p.ws + OFF_QK1); bf16_t* VTz = (bf16_t*)(p.ws + OFF_VT);
            for (int i = blockIdx.x * 512 + threadIdx.x; i < 48 * 128; i += gridDim.x * 512)
                *(u32x4*)(QKz + (size_t)(MR + 16 + (i >> 7)) * 2048 + 1024 + (i & 127) * 8) = (u32x4){0u, 0u, 0u, 0u};
            for (int i = blockIdx.x * 512 + threadIdx.x; i < 1024 * 6; i += gridDim.x * 512)
                *(u32x4*)(VTz + (size_t)(i / 6) * MP + MR + 16 + (i % 6) * 8) = (u32x4){0u, 0u, 0u, 0u};
        }
        S.init(MR, 2048, G, c); pg8::gemm_phase(lds, g, S, E);
        pg8::Gemm g2{(const bf16_t*)(p.ws + OFF_WIN1) + 2048ull * 1024, HB, 1024, MR, 1024};
        EpiVT E2{(bf16_t*)(p.ws + OFF_VT), SS + 1 * MP};
        S.init(1024, MR, G, c); pg8::gemm_phase(lds, g2, S, E2);
    }
    xcd_barrier(xb);
    attn_phase(p, smem);
    xcd_barrier(xb);
#if DUP == 1
    attn_phase(p, smem);
    xcd_barrier(xb);
#endif
    {
        pg8::Gemm g{(const bf16_t*)(p.ws + OFF_AO), (const bf16_t*)(p.ws + OFF_WOUT1), MR, 1024, 1024};
        EpiRes<1> E{H, HB, SS + 2 * MP, nullptr, nullptr};
        S.init(MR, 1024, G, c); pg8::gemm_phase(lds, g, S, E);
    }
    xcd_barrier(xb);
    {
        pg8::Gemm g{HB, (const bf16_t*)(p.ws + OFF_WM11), MR, 4096, 1024};
        EpiUp E{HID, SS + 2 * MP};
        S.init(MR, 4096, G, c); pg8::gemm_phase(lds, g, S, E);
    }
    xcd_barrier(xb);
    {
        pg8::Gemm g{HID, (const bf16_t*)(p.ws + OFF_WM21), MR, 1024, 4096};
        EpiRes<1, false> E{H, HB, SS + 3 * MP, nullptr, nullptr};
        S.init(MR, 1024, G, c); pg8::gemm_phase(lds, g, S, E);
    }
    xcd_barrier(xb);
#if DUP == 8
#pragma unroll 1
    for (int i = 0; i < 20; ++i) xcd_barrier(xb);
#endif
    final_phase(p);
#if DUP == 5
    xcd_barrier(xb);
    {
        pg8::Gemm g{HID, (const bf16_t*)(p.ws + OFF_WM21), MR, 1024, 4096};
        EpiRes<1> E{H, HB, SS + 3 * MP, nullptr, nullptr};
        S.init(MR, 1024, G, c); pg8::gemm_phase(lds, g, S, E);
    }
#endif
}

extern "C" void kernel_launch(void* const* d_in, const int* in_sizes, int n_in, void* d_out, int out_size, void* d_ws, size_t ws_size, hipStream_t stream) {
    static int grid_blocks = 0;
    if (!grid_blocks) {
        int dev = 0, cus = 0, per_cu = 0;
        hipGetDevice(&dev);
        hipDeviceGetAttribute(&cus, hipDeviceAttributeMultiprocessorCount, dev);
        hipFuncSetAttribute((const void*)fwd_megakernel, hipFuncAttributeMaxDynamicSharedMemorySize, LDS_BYTES);
        hipOccupancyMaxActiveBlocksPerMultiprocessor(&per_cu, fwd_megakernel, 512, LDS_BYTES);
        if (per_cu < 1) per_cu = 1;
        grid_blocks = cus * per_cu;
        if (grid_blocks > 256) grid_blocks = 256;
    }
    Params p{};
    const float** f = (const float**)&p;
    for (int i = 0; i < 22; ++i) f[i] = (const float*)d_in[i];
    p.out = (float*)d_out;
    p.ws = (unsigned char*)d_ws;
    void* args[] = {&p};
    (void)hipMemsetAsync((unsigned char*)d_ws + OFF_BAR, 0, XCD_BAR_WORDS * sizeof(unsigned), stream);
    hipError_t e = hipLaunchCooperativeKernel((const void*)fwd_megakernel, dim3(grid_blocks), dim3(512), args, LDS_BYTES, stream);
    if (e != hipSuccess) fprintf(stderr, "cooperative launch failed: %s (grid %d)\n", hipGetErrorString(e), grid_blocks);
}
```

```cpp
#include <hip/hip_runtime.h>
#include <hip/hip_cooperative_groups.h>
#include <cstdio>
#include <cstdint>
namespace cg = cooperative_groups;

#define LAS __attribute__((address_space(3)))
#define DI __device__ __forceinline__
typedef unsigned short bf16_t;
typedef short bf16x8 __attribute__((ext_vector_type(8)));
typedef short bf16x4 __attribute__((ext_vector_type(4)));
typedef float f32x4 __attribute__((ext_vector_type(4)));
typedef float f32x2 __attribute__((ext_vector_type(2)));
typedef float f32x16 __attribute__((ext_vector_type(16)));
typedef unsigned u32x4 __attribute__((ext_vector_type(4)));
typedef unsigned u32x2 __attribute__((ext_vector_type(2)));
typedef __bf16 hbf2 __attribute__((ext_vector_type(2)));

constexpr int MR = 32768;
constexpr int MV = 32896;
constexpr int MP = 33024;
constexpr int TSEQ = 4112;
constexpr float EPS = 1e-6f;
constexpr float LAMBDA_INIT = 0.35550906759096934f;
constexpr float LOG2E = 1.4426950408889634f;

constexpr size_t OFF_WIN0 = 0;
constexpr size_t OFF_WOUT0 = OFF_WIN0 + 6144ull * 1024 * 2;
constexpr size_t OFF_WM10 = OFF_WOUT0 + 1024ull * 2048 * 2;
constexpr size_t OFF_WM20 = OFF_WM10 + 4096ull * 1024 * 2;
constexpr size_t OFF_WIN1 = OFF_WM20 + 4096ull * 1024 * 2;
constexpr size_t OFF_WOUT1 = OFF_WIN1 + 3072ull * 1024 * 2;
constexpr size_t OFF_WM11 = OFF_WOUT1 + 1024ull * 1024 * 2;
constexpr size_t OFF_WM21 = OFF_WM11 + 4096ull * 1024 * 2;
constexpr size_t OFF_WLRU = OFF_WM21 + 4096ull * 1024 * 2;
constexpr size_t OFF_LI = OFF_WLRU + 2ull * 8 * 128 * 128 * 2;
constexpr size_t OFF_LF = OFF_LI + (size_t)MP * 16;
constexpr size_t OFF_SS = OFF_LF + (size_t)MP * 16;
constexpr size_t OFF_HSS = OFF_SS + 4ull * MP * 4;
constexpr size_t OFF_ROPE = OFF_HSS + (size_t)MP * 16;
constexpr size_t OFF_MISC = OFF_ROPE + (size_t)TSEQ * 64;
constexpr size_t OFF_BAR = OFF_MISC + 256;
constexpr size_t OFF_HB = OFF_BAR + 13824;
constexpr size_t OFF_R2 = OFF_HB + (size_t)MP * 2048;
constexpr size_t OFF_R3 = OFF_R2 + (size_t)MP * 8192;
constexpr size_t WS_END = OFF_R3 + (size_t)MP * 4096;
constexpr size_t OFF_H = OFF_R2;
constexpr size_t OFF_HID = OFF_R2 + (size_t)MP * 4096;
constexpr size_t OFF_QK1 = OFF_HID;
constexpr size_t OFF_VT = OFF_R3;
constexpr size_t OFF_AO = OFF_R3 + (size_t)MP * 2048;
static_assert(WS_END <= 536870912ull, "workspace");

constexpr int LDS_BYTES = 163840;

struct Params {
    const float *x, *meta, *norm_mix, *norm_mlp, *norm_final, *ab_w_in, *ab_if_bias, *mlstm_norm, *conv_w, *conv_b,
        *w_r, *b_r, *w_i, *b_i, *lam, *ab_w_out, *c_w_in, *c_lambda, *c_subln, *c_w_out, *mlp_w1, *mlp_w2;
    float* out;
    unsigned char* ws;
};

DI unsigned pk2(float a, float b) { f32x2 v = {a, b}; hbf2 r = __builtin_convertvector(v, hbf2); return __builtin_bit_cast(unsigned, r); }
DI bf16_t f2bf(float a) { return (bf16_t)(pk2(a, 0.f) & 0xffffu); }
DI float bf2f(bf16_t b) { return __uint_as_float(((unsigned)b) << 16); }
DI float bflo(unsigned u) { return __uint_as_float(u << 16); }
DI float bfhi(unsigned u) { return __uint_as_float(u & 0xffff0000u); }
DI float sigmoidf_(float x) { return __builtin_amdgcn_rcpf(1.0f + __expf(-x)); }
DI float gelu_tanh(float x) { const float z = 1.5957691216057308f * (x + 0.044715f * x * x * x); return x * sigmoidf_(z); }
DI int tid_fresh() { int t = threadIdx.x; asm volatile("" : "+v"(t)); return t; }
DI float sum_x32(float x) { auto r = __builtin_amdgcn_permlane32_swap(__float_as_uint(x), __float_as_uint(x), false, false); return __uint_as_float(r[0]) + __uint_as_float(r[1]); }
DI float max_x32(float x) { auto r = __builtin_amdgcn_permlane32_swap(__float_as_uint(x), __float_as_uint(x), false, false); return fmaxf(__uint_as_float(r[0]), __uint_as_float(r[1])); }
DI float sum_x16(float x) { auto r = __builtin_amdgcn_permlane16_swap(__float_as_uint(x), __float_as_uint(x), false, false); return __uint_as_float(r[0]) + __uint_as_float(r[1]); }
DI float sum_x16_x32(float x) { return sum_x32(sum_x16(x)); }

DI float wave_sum(float v) {
#pragma unroll
    for (int o = 32; o >= 1; o >>= 1) v += __shfl_xor(v, o);
    return v;
}

template <int CTRL, int ROWMASK> DI float dpp_mov(float old, float src) {
    return __builtin_bit_cast(float, __builtin_amdgcn_update_dpp(__builtin_bit_cast(int, old), __builtin_bit_cast(int, src), CTRL, ROWMASK, 0xf, false));
}
DI float wave_scan_add(float x) {
    x += dpp_mov<0x111, 0xf>(0.f, x); x += dpp_mov<0x112, 0xf>(0.f, x); x += dpp_mov<0x114, 0xf>(0.f, x); x += dpp_mov<0x118, 0xf>(0.f, x);
    x += dpp_mov<0x142, 0xa>(0.f, x); x += dpp_mov<0x143, 0xc>(0.f, x);
    return x;
}
DI float wave_scan_max(float x) {
    const float ninf = -INFINITY;
    x = fmaxf(x, dpp_mov<0x111, 0xf>(ninf, x)); x = fmaxf(x, dpp_mov<0x112, 0xf>(ninf, x)); x = fmaxf(x, dpp_mov<0x114, 0xf>(ninf, x)); x = fmaxf(x, dpp_mov<0x118, 0xf>(ninf, x));
    x = fmaxf(x, dpp_mov<0x142, 0xa>(ninf, x)); x = fmaxf(x, dpp_mov<0x143, 0xc>(ninf, x));
    return x;
}

namespace pg8 {
constexpr int BM = 256, BK = 64, HALF = 128, HTB = HALF * BK * 2, STAGE_BYTES = 8 * HTB, NXCD = 8, WGM = 8;
__host__ __device__ __forceinline__ int lds_byte(int r, int c) { const int st = (r >> 4) * 2 + (c >> 5), rr = r & 15, cc = c & 31, ob = rr * 64 + cc * 2; return st * 1024 + (ob ^ (((ob >> 9) & 1) << 5)); }
__host__ __device__ __forceinline__ void stage_rc(int b, int& R, int& C) { const int st = b / 1024, sb = b % 1024, swz = sb ^ (((sb >> 9) & 1) << 5); R = (st >> 1) * 16 + swz / 64; C = (st & 1) * 32 + (swz % 64) / 2; }
__host__ __device__ __forceinline__ int perm32(int rho) { const int n = rho >> 4, i = rho & 15; return 8 * (i >> 2) + 4 * n + (i & 3); }
struct Unit { int pm, pn; };
struct Gemm { const bf16_t* A; const bf16_t* Bt; int M, N, K; };
struct StaticOrder {
    int nM, nN, nwg, G, c;
    __device__ void init(int M, int N, int G_, int c_) { nM = M / BM; nN = N / BM; nwg = nM * nN; G = G_; c = c_; }
    __device__ bool next(int i, Unit& u) const {
        const long L = (long)i * G + c; if (L >= nwg) return false;
        int wgid = (int)L; { const int q = nwg / NXCD, r = nwg % NXCD, xcd = wgid % NXCD, off = wgid / NXCD; wgid = (xcd < r ? xcd * (q + 1) : r * (q + 1) + (xcd - r) * q) + off; }
        const int nig = WGM * nN, gid = wgid / nig, fm = gid * WGM, gsz = (nM - fm) < WGM ? (nM - fm) : WGM;
        u.pm = fm + ((wgid % nig) % gsz); u.pn = (wgid % nig) / gsz; return true;
    }
};

template <class Epi>
__device__ __forceinline__ void gemm_phase(LAS unsigned char* lds, const Gemm g, const StaticOrder& S, const Epi& E) {
    const int tid = tid_fresh(), wid = __builtin_amdgcn_readfirstlane(tid >> 6), lane = tid & 63, wr = wid >> 2, wc = wid & 3, fr = lane & 15, fq = lane >> 4;
    const int K = g.K, nt = K / BK;
    unsigned voffA[2], voffB[2];
#pragma unroll
    for (int i = 0; i < 2; ++i) { int R, C; stage_rc(tid * 16 + i * 8192, R, C); const int Rb = Epi::PERM ? ((R & ~31) + perm32(R & 31)) : R;
        voffA[i] = (unsigned)(R * K + C) * 2u; voffB[i] = (unsigned)(Rb * K + C) * 2u; }
    const size_t kstep = (size_t)(BK * 2);
    const size_t hstep = (size_t)HALF * K * 2;
    const size_t tstep = 2 * hstep;
    const unsigned ldsw = (unsigned)wid * 1024u;
    const int aoff = lds_byte(wr * 64 + fr, fq * 8), boff = lds_byte(wc * 32 + fr, fq * 8);
#define PG8_SA(b, h) (((b) * 2 + (h)) * HTB)
#define PG8_SB(b, h) ((4 + (b) * 2 + (h)) * HTB)
#define PG8_STAGE(bufoff, gbase, voff) do { _Pragma("unroll") for (int _i = 0; _i < 2; ++_i) \
        __builtin_amdgcn_global_load_lds((const unsigned*)((const char*)(gbase) + (voff)[_i]), (LAS unsigned*)(lds + (bufoff) + ldsw + _i * 8192), 16, 0, 0); } while (0)
#define PG8_LDA(dst, b, h) do { _Pragma("unroll") for (int m = 0; m < 4; ++m) _Pragma("unroll") for (int k = 0; k < 2; ++k) dst[m][k] = *(const LAS bf16x8*)(lds + PG8_SA(b, h) + aoff + m * 2048 + k * 1024); } while (0)
#define PG8_LDB(dst, b, h) do { _Pragma("unroll") for (int n = 0; n < 2; ++n) _Pragma("unroll") for (int k = 0; k < 2; ++k) dst[n][k] = *(const LAS bf16x8*)(lds + PG8_SB(b, h) + boff + n * 2048 + k * 1024); } while (0)
#define PG8_MMA(ai, bj, At, Bt) do { __builtin_amdgcn_s_setprio(1); _Pragma("unroll") for (int m = 0; m < 4; ++m) _Pragma("unroll") for (int n = 0; n < 2; ++n) _Pragma("unroll") for (int k = 0; k < 2; ++k) \
        acc[ai][bj][m][n] = __builtin_amdgcn_mfma_f32_16x16x32_bf16(Bt[n][k], At[m][k], acc[ai][bj][m][n], 0, 0, 0); __builtin_amdgcn_s_setprio(0); } while (0)
#define PG8_WAIT_V(n) asm volatile("s_waitcnt vmcnt(" #n ")" ::: "memory")
#define PG8_WAIT_L(n) asm volatile("s_waitcnt lgkmcnt(" #n ")" ::: "memory")
#define PG8_BAR __builtin_amdgcn_s_barrier()
#define PG8_SCHED __builtin_amdgcn_sched_barrier(0)
    Unit cur, nxt; int ui = 0;
    if (!S.next(0, cur)) return;
    f32x4 acc[2][2][4][2];
#pragma unroll
    for (int a = 0; a < 2; ++a)
#pragma unroll
        for (int b = 0; b < 2; ++b)
#pragma unroll
            for (int m = 0; m < 4; ++m)
#pragma unroll
                for (int n = 0; n < 2; ++n) acc[a][b][m][n] = (f32x4){0.f, 0.f, 0.f, 0.f};
    bf16x8 At[4][2], B0[2][2], B1[2][2];
    const char* cA = (const char*)g.A + (size_t)cur.pm * tstep; const char* cB = (const char*)g.Bt + (size_t)cur.pn * tstep;
    PG8_STAGE(PG8_SB(0, 0), cB, voffB); PG8_STAGE(PG8_SA(0, 0), cA, voffA); PG8_STAGE(PG8_SB(0, 1), cB + hstep, voffB); PG8_STAGE(PG8_SA(0, 1), cA + hstep, voffA);
    if (wr == 1) PG8_BAR;
    PG8_WAIT_V(4); PG8_BAR;
    PG8_STAGE(PG8_SB(1, 0), cB + kstep, voffB); PG8_STAGE(PG8_SA(1, 0), cA + kstep, voffA); PG8_STAGE(PG8_SB(1, 1), cB + hstep + kstep, voffB);
    PG8_WAIT_V(6); PG8_BAR;
    for (;;) {
        const bool has_next = S.next(ui + 1, nxt);
        const char* nA = has_next ? (const char*)g.A + (size_t)nxt.pm * tstep : cA; const char* nB = has_next ? (const char*)g.Bt + (size_t)nxt.pn * tstep : cB;
        for (int t = 0; t < nt; t += 2) {
            const bool last = (t == nt - 2);
            const char* a1 = cA + (size_t)(t + 1) * kstep;
            const char* a2 = last ? nA : cA + (size_t)(t + 2) * kstep; const char* b2 = last ? nB : cB + (size_t)(t + 2) * kstep;
            const char* a3 = a2 + kstep; const char* b3 = b2 + kstep;
            PG8_LDB(B0, 0, 0); PG8_SCHED; PG8_LDA(At, 0, 0); PG8_STAGE(PG8_SA(1, 1), a1 + hstep, voffA);
            PG8_WAIT_L(8); PG8_BAR; PG8_WAIT_L(0); PG8_MMA(0, 0, At, B0); PG8_BAR; PG8_SCHED;
            PG8_LDB(B1, 0, 1); PG8_STAGE(PG8_SB(0, 0), b2, voffB);
            PG8_BAR; PG8_WAIT_L(0); PG8_MMA(0, 1, At, B1); PG8_BAR;
            PG8_LDA(At, 0, 1); PG8_STAGE(PG8_SA(0, 0), a2, voffA);
            PG8_BAR; PG8_WAIT_L(0); PG8_MMA(1, 0, At, B0); PG8_BAR; PG8_SCHED;
            PG8_STAGE(PG8_SB(0, 1), b2 + hstep, voffB);
            PG8_WAIT_V(6); PG8_BAR; PG8_MMA(1, 1, At, B1); PG8_BAR;
            PG8_LDB(B0, 1, 0); PG8_SCHED; PG8_LDA(At, 1, 0); PG8_STAGE(PG8_SA(0, 1), a2 + hstep, voffA);
            PG8_WAIT_L(8); PG8_BAR; PG8_WAIT_L(0); PG8_MMA(0, 0, At, B0); PG8_BAR; PG8_SCHED;
            PG8_LDB(B1, 1, 1); PG8_STAGE(PG8_SB(1, 0), b3, voffB);
            PG8_BAR; PG8_WAIT_L(0); PG8_MMA(0, 1, At, B1); PG8_BAR;
            PG8_LDA(At, 1, 1); PG8_STAGE(PG8_SA(1, 0), a3, voffA);
            PG8_BAR; PG8_WAIT_L(0); PG8_MMA(1, 0, At, B0); PG8_BAR; PG8_SCHED;
            PG8_STAGE(PG8_SB(1, 1), b3 + hstep, voffB);
            PG8_WAIT_V(6); PG8_BAR; PG8_MMA(1, 1, At, B1); PG8_BAR;
        }
        E(acc, cur, wr, wc, fr, fq);
        if (!has_next) break;
#pragma unroll
        for (int a = 0; a < 2; ++a)
#pragma unroll
            for (int b = 0; b < 2; ++b)
#pragma unroll
                for (int m = 0; m < 4; ++m)
#pragma unroll
                    for (int n = 0; n < 2; ++n) acc[a][b][m][n] = (f32x4){0.f, 0.f, 0.f, 0.f};
        cur = nxt; cA = nA; cB = nB; ++ui;
    }
    PG8_WAIT_V(0);
    if (wr == 0) PG8_BAR;
    PG8_BAR;
#undef PG8_SA
#undef PG8_SB
#undef PG8_STAGE
#undef PG8_LDA
#undef PG8_LDB
#undef PG8_MMA
#undef PG8_WAIT_V
#undef PG8_WAIT_L
#undef PG8_BAR
#undef PG8_SCHED
}
}
using pg8::Unit;

struct EpiIn0 {
    static constexpr bool PERM = true;
    bf16_t* T1; bf16_t* OG;
    DI void operator()(const f32x4 (&acc)[2][2][4][2], const Unit& u, int wr, int wc, int fr, int fq) const {
        const int row0 = u.pm * 256 + wr * 64 + fr;
        bf16_t* base; int ldc, colt, act;
        if (u.pn < 16) { base = T1; ldc = 4096; colt = u.pn * 256; act = 0; }
        else { base = OG; ldc = 2048; colt = (u.pn - 16) * 256; act = (u.pn < 20) ? 1 : 2; }
        const int col0 = colt + wc * 32 + 8 * fq;
#pragma unroll
        for (int ai = 0; ai < 2; ++ai)
#pragma unroll
            for (int m = 0; m < 4; ++m) {
                bf16_t* rowp = base + (size_t)(row0 + ai * 128 + m * 16) * ldc + col0;
#pragma unroll
                for (int bj = 0; bj < 2; ++bj) {
                    f32x4 v0 = acc[ai][bj][m][0], v1 = acc[ai][bj][m][1];
                    if (act == 1) {
#pragma unroll
                        for (int j = 0; j < 4; ++j) { v0[j] = sigmoidf_(v0[j]); v1[j] = sigmoidf_(v1[j]); }
                    } else if (act == 2) {
#pragma unroll
                        for (int j = 0; j < 4; ++j) { v0[j] = gelu_tanh(v0[j]); v1[j] = gelu_tanh(v1[j]); }
                    }
                    u32x4 w; w.x = pk2(v0[0], v0[1]); w.y = pk2(v0[2], v0[3]); w.z = pk2(v1[0], v1[1]); w.w = pk2(v1[2], v1[3]);
                    *(u32x4*)(rowp + bj * 128) = w;
                }
            }
    }
};

template <int MODE, bool WRITE_HB = true>
struct EpiRes {
    static constexpr bool PERM = false;
    float* h; bf16_t* hb; float* ss; const float* x; const float* meta;
    DI void operator()(const f32x4 (&acc)[2][2][4][2], const Unit& u, int wr, int wc, int fr, int fq) const {
        const int row0 = u.pm * 256 + wr * 64 + fr, col0 = u.pn * 256 + wc * 32 + 4 * fq;
#pragma unroll
        for (int ai = 0; ai < 2; ++ai)
#pragma unroll
            for (int m = 0; m < 4; ++m) {
                const int r = row0 + ai * 128 + m * 16;
                const float* rp;
                if (MODE == 0) rp = x + (size_t)r * 1024;
                else rp = h + (size_t)r * 1024;
                float sq = 0.f;
#pragma unroll
                for (int bj = 0; bj < 2; ++bj)
#pragma unroll
                    for (int n = 0; n < 2; ++n) {
                        const int c = col0 + bj * 128 + n * 16;
                        f32x4 rv = rp ? *(const f32x4*)(rp + c) : (f32x4){0.f, 0.f, 0.f, 0.f};
                        f32x4 v = acc[ai][bj][m][n] + rv;
                        *(f32x4*)(h + (size_t)r * 1024 + c) = v;
                        if (WRITE_HB) {
                            u32x2 w; w.x = pk2(v[0], v[1]); w.y = pk2(v[2], v[3]);
                            *(u32x2*)(hb + (size_t)r * 1024 + c) = w;
                        }
                        sq += v[0] * v[0] + v[1] * v[1] + v[2] * v[2] + v[3] * v[3];
                    }
                sq = sum_x16_x32(sq);
                if (fq == 0) atomicAdd(ss + r, sq);
            }
    }
};

struct EpiUp {
    static constexpr bool PERM = true;
    bf16_t* HID; const float* ss;
    DI void operator()(const f32x4 (&acc)[2][2][4][2], const Unit& u, int wr, int wc, int fr, int fq) const {
        const int row0 = u.pm * 256 + wr * 64 + fr, col0 = u.pn * 256 + wc * 32 + 8 * fq;
#pragma unroll
        for (int ai = 0; ai < 2; ++ai)
#pragma unroll
            for (int m = 0; m < 4; ++m) {
                const int r = row0 + ai * 128 + m * 16;
                const float rstd = rsqrtf(ss[r] * (1.0f / 1024.0f) + EPS);
                bf16_t* rowp = HID + (size_t)r * 4096 + col0;
#pragma unroll
                for (int bj = 0; bj < 2; ++bj) {
                    f32x4 v0 = acc[ai][bj][m][0] * rstd, v1 = acc[ai][bj][m][1] * rstd;
#pragma unroll
                    for (int j = 0; j < 4; ++j) { float a = fmaxf(v0[j], 0.f), b = fmaxf(v1[j], 0.f); v0[j] = a * a; v1[j] = b * b; }
                    u32x4 w; w.x = pk2(v0[0], v0[1]); w.y = pk2(v0[2], v0[3]); w.z = pk2(v1[0], v1[1]); w.w = pk2(v1[2], v1[3]);
                    *(u32x4*)(rowp + bj * 128) = w;
                }
            }
    }
};

struct EpiQK {
    static constexpr bool PERM = true;
    bf16_t* QK; const float* ss; const float* rope;
    DI void operator()(const f32x4 (&acc)[2][2][4][2], const Unit& u, int wr, int wc, int fr, int fq) const {
        const int row0 = u.pm * 256 + wr * 64 + fr, col0 = u.pn * 256 + wc * 32 + 8 * fq;
        const bool rot = (wc & 1) == 0;
#pragma unroll
        for (int ai = 0; ai < 2; ++ai)
#pragma unroll
            for (int m = 0; m < 4; ++m) {
                const int r = row0 + ai * 128 + m * 16;
                const float rstd = rsqrtf(ss[r] * (1.0f / 1024.0f) + EPS);
                const int t = r < MR ? 16 + (r & 4095) : ((r - MR) & 15);
                f32x4 cs[2], sn[2];
                if (rot) {
                    cs[0] = *(const f32x4*)(rope + t * 16); cs[1] = *(const f32x4*)(rope + t * 16 + 4);
                    sn[0] = *(const f32x4*)(rope + t * 16 + 8); sn[1] = *(const f32x4*)(rope + t * 16 + 12);
                }
                bf16_t* rowp = QK + (size_t)r * 2048 + col0;
#pragma unroll
                for (int bj = 0; bj < 2; ++bj) {
                    f32x4 v[2]; v[0] = acc[ai][bj][m][0] * rstd; v[1] = acc[ai][bj][m][1] * rstd;
                    if (rot) {
#pragma unroll
                        for (int n = 0; n < 2; ++n)
#pragma unroll
                            for (int j = 0; j < 4; ++j) {
                                const auto sw = __builtin_amdgcn_permlane16_swap(__float_as_uint(v[n][j]), __float_as_uint(v[n][j]), false, false);
                                const float other = __uint_as_float((fq & 1) ? sw[0] : sw[1]);
                                const float mine = v[n][j];
                                const float ra = mine * cs[n][j] - other * sn[n][j];
                                const float rb = mine * cs[n][j] + other * sn[n][j];
                                v[n][j] = fq == 0 ? ra : (fq == 1 ? rb : mine);
                            }
                    }
                    u32x4 w; w.x = pk2(v[0][0], v[0][1]); w.y = pk2(v[0][2], v[0][3]); w.z = pk2(v[1][0], v[1][1]); w.w = pk2(v[1][2], v[1][3]);
                    *(u32x4*)(rowp + bj * 128) = w;
                }
            }
    }
};

struct EpiVT {
    static constexpr bool PERM = true;
    bf16_t* VT; const float* ss;
    DI void operator()(const f32x4 (&acc)[2][2][4][2], const Unit& u, int wr, int wc, int fr, int fq) const {
        const int row0 = u.pm * 256 + wr * 64 + fr, col0 = u.pn * 256 + wc * 32 + 8 * fq;
        f32x4 rs[2][2];
#pragma unroll
        for (int bj = 0; bj < 2; ++bj)
#pragma unroll
            for (int n = 0; n < 2; ++n) {
                f32x4 s = *(const f32x4*)(ss + col0 + bj * 128 + 4 * n);
#pragma unroll
                for (int j = 0; j < 4; ++j) rs[bj][n][j] = rsqrtf(s[j] * (1.0f / 1024.0f) + EPS);
            }
#pragma unroll
        for (int ai = 0; ai < 2; ++ai)
#pragma unroll
            for (int m = 0; m < 4; ++m) {
                bf16_t* rowp = VT + (size_t)(row0 + ai * 128 + m * 16) * MP + col0;
#pragma unroll
                for (int bj = 0; bj < 2; ++bj) {
                    f32x4 v0 = acc[ai][bj][m][0] * rs[bj][0], v1 = acc[ai][bj][m][1] * rs[bj][1];
                    bf16_t* g16 = rowp + bj * 128 - 8 * (fq & 1);
                    u32x2 w0; w0.x = pk2(v0[0], v0[1]); w0.y = pk2(v0[2], v0[3]);
                    u32x2 w1; w1.x = pk2(v1[0], v1[1]); w1.y = pk2(v1[2], v1[3]);
                    *(u32x2*)(g16 + ((fq & 1) ? 4 : 0)) = w0;
                    *(u32x2*)(g16 + ((fq & 1) ? 12 : 8)) = w1;
                }
            }
    }
};

DI float wt_kscale(const Params& p, int job, int k) {
    switch (job) {
        case 0: return p.norm_mix[k];
        case 1: return k < 1024 ? p.mlstm_norm[k] : 1.0f;
        case 2: return p.norm_mlp[k];
        case 4: return p.norm_mix[1024 + k];
        case 5: return p.c_subln[k & 127] * (1.0f - LAMBDA_INIT);
        case 6: return p.norm_mlp[1024 + k];
        default: return 1.0f;
    }
}
DI void wt_colmap(int job, int n, int& scol, float& cs) {
    scol = n; cs = 1.0f;
    if (job == 0) {
        if (n < 3072) { cs = (n >= 1024 && n < 2048) ? 0.0625f : 1.0f; }
        else if (n < 4096) scol = n + 1032;
        else if (n < 5120) scol = n - 1024;
        else scol = n + 8;
    } else if (job == 4) {
        if (n < 1024) cs = 0.125f * LOG2E;
    }
}

DI void wt_convert(const Params& p, unsigned char* smem, int job_lo, int job_hi, int bid, int nblk) {
    const int tid = tid_fresh();
    float* tile = (float*)smem;
    for (int job = job_lo; job < job_hi; ++job) {
        const float* src; int ld, K, N; size_t off;
        switch (job) {
            case 0: src = p.ab_w_in; ld = 6152; K = 1024; N = 6144; off = OFF_WIN0; break;
            case 1: src = p.ab_w_out; ld = 1024; K = 2048; N = 1024; off = OFF_WOUT0; break;
            case 2: src = p.mlp_w1; ld = 4096; K = 1024; N = 4096; off = OFF_WM10; break;
            case 3: src = p.mlp_w2; ld = 1024; K = 4096; N = 1024; off = OFF_WM20; break;
            case 4: src = p.c_w_in; ld = 3072; K = 1024; N = 3072; off = OFF_WIN1; break;
            case 5: src = p.c_w_out; ld = 1024; K = 1024; N = 1024; off = OFF_WOUT1; break;
            case 6: src = p.mlp_w1 + 1024ull * 4096; ld = 4096; K = 1024; N = 4096; off = OFF_WM11; break;
            default: src = p.mlp_w2 + 4096ull * 1024; ld = 1024; K = 4096; N = 1024; off = OFF_WM21; break;
        }
        bf16_t* dst = (bf16_t*)(p.ws + off);
        const int tn = N / 256, tk = K / 64;
        for (int t = bid; t < tn * tk; t += nblk) {
            const int n0 = (t % tn) * 256, k0 = (t / tn) * 64;
            {
                const int tx = tid & 63, ty = tid >> 6;
                float ksc[8];
#pragma unroll
                for (int i = 0; i < 8; ++i) ksc[i] = wt_kscale(p, job, k0 + ty * 8 + i);
#pragma unroll
                for (int cg = 0; cg < 4; ++cg) {
                    int scol; float cs; wt_colmap(job, n0 + cg * 64 + tx, scol, cs);
#pragma unroll
                    for (int i = 0; i < 8; ++i) tile[(ty * 8 + i) * 257 + cg * 64 + tx] = src[(size_t)(k0 + ty * 8 + i) * ld + scol] * (cs * ksc[i]);
                }
            }
            __syncthreads();
#pragma unroll
            for (int q = 0; q < 4; ++q) {
                const int vid = tid + 512 * q, nl = vid >> 3, ks = vid & 7;
                float v[8];
#pragma unroll
                for (int j = 0; j < 8; ++j) v[j] = tile[(ks * 8 + j) * 257 + nl];
                u32x4 w; w.x = pk2(v[0], v[1]); w.y = pk2(v[2], v[3]); w.z = pk2(v[4], v[5]); w.w = pk2(v[6], v[7]);
                *(u32x4*)(dst + (size_t)(n0 + nl) * K + k0 + ks * 8) = w;
            }
            __syncthreads();
        }
    }
}

DI void prologue_phase(const Params& p, unsigned char* smem) {
    const int tid = tid_fresh(), lane = tid & 63, wid = tid >> 6;
    wt_convert(p, smem, 0, 1, blockIdx.x, gridDim.x);
    {
        bf16_t* dst = (bf16_t*)(p.ws + OFF_WLRU);
        for (int i = blockIdx.x * 512 + tid; i < 2 * 8 * 128 * 128; i += gridDim.x * 512) {
            const int d = i & 127, e = (i >> 7) & 127, which = (i >> 14) & 1, n = i >> 15;
            const float* w = which ? p.w_i : p.w_r;
            dst[i] = f2bf(w[(n * 128 + d) * 128 + e]);
        }
    }
    if (blockIdx.x == 0 && wid == 0) {
        const float a = wave_sum(p.c_lambda[lane] * p.c_lambda[64 + lane]);
        const float c = wave_sum(p.c_lambda[128 + lane] * p.c_lambda[192 + lane]);
        if (lane == 0) ((float*)(p.ws + OFF_MISC))[0] = expf(a) - expf(c) + LAMBDA_INIT;
    }
    {
        float* z = (float*)(p.ws + OFF_SS);
        for (int i = blockIdx.x * 512 + tid; i < 8 * MP; i += gridDim.x * 512) z[i] = 0.f;
        float* rope = (float*)(p.ws + OFF_ROPE);
        for (int i = blockIdx.x * 512 + tid; i < TSEQ * 8; i += gridDim.x * 512) {
            const int t = i >> 3, j = i & 7;
            const float invf[8] = {1.0f, 0.1939227432012558f, 0.03760603070259094f, 0.007292664609849453f, 0.0014142135623842478f,
                                   0.00027424818836152554f, 5.3182957344688475e-05f, 1.0313385246263351e-05f};
            float f = 1.0f;
#pragma unroll
            for (int q = 0; q < 8; ++q) f = (j == q) ? invf[q] : f;
            const float ang = (float)t * f;
            const float kk = rintf(ang * 0.15915494309189535f);
            float r = fmaf(-kk, 6.28125f, ang);
            r = fmaf(-kk, 1.9353071795864769e-3f, r);
            rope[t * 16 + j] = __cosf(r);
            rope[t * 16 + 8 + j] = __sinf(r);
        }
    }
    {
        float* wg = (float*)smem;
        __syncthreads();
        for (int i = tid; i < 8192; i += 512) { const int k = i >> 3, j = i & 7; wg[i] = p.ab_w_in[(size_t)k * 6152 + 4096 + j] * p.norm_mix[k]; }
        __syncthreads();
        bf16_t* hn = (bf16_t*)(p.ws + OFF_HB);
        float* LI = (float*)(p.ws + OFF_LI); float* LF = (float*)(p.ws + OFF_LF);
        const int rstep = gridDim.x * 8;
        int r = blockIdx.x * 8 + wid;
        f32x4 nx[4];
        auto load_row = [&](int rr) __attribute__((always_inline)) {
            const float* s = rr < MR ? p.x + (size_t)rr * 1024 : p.meta + (size_t)(rr - MR) * 1024;
#pragma unroll
            for (int i = 0; i < 4; ++i) nx[i] = *(const f32x4*)(s + i * 256 + lane * 4);
        };
        if (r < MR + 16) load_row(r);
        for (; r < MR + 16; r += rstep) {
            f32x4 v[4];
#pragma unroll
            for (int i = 0; i < 4; ++i) v[i] = nx[i];
            if (r + rstep < MR + 16) load_row(r + rstep);
            float sq = 0.f;
#pragma unroll
            for (int i = 0; i < 4; ++i) sq += v[i][0] * v[i][0] + v[i][1] * v[i][1] + v[i][2] * v[i][2] + v[i][3] * v[i][3];
            float g[8];
#pragma unroll
            for (int j = 0; j < 8; ++j) g[j] = 0.f;
#pragma unroll
            for (int i = 0; i < 4; ++i) {
#pragma unroll
                for (int e = 0; e < 4; ++e) {
                    const float* wr_ = wg + (i * 256 + lane * 4 + e) * 8;
                    const f32x4 w0 = *(const f32x4*)wr_, w1 = *(const f32x4*)(wr_ + 4);
                    g[0] += v[i][e] * w0[0]; g[1] += v[i][e] * w0[1]; g[2] += v[i][e] * w0[2]; g[3] += v[i][e] * w0[3];
                    g[4] += v[i][e] * w1[0]; g[5] += v[i][e] * w1[1]; g[6] += v[i][e] * w1[2]; g[7] += v[i][e] * w1[3];
                }
            }
            sq = wave_sum(sq);
            const float rstd = rsqrtf(sq * (1.0f / 1024.0f) + EPS);
#pragma unroll
            for (int i = 0; i < 4; ++i) {
                u32x2 w; w.x = pk2(v[i][0] * rstd, v[i][1] * rstd); w.y = pk2(v[i][2] * rstd, v[i][3] * rstd);
                *(u32x2*)(hn + (size_t)r * 1024 + i * 256 + lane * 4) = w;
            }
            float h4[4], h2[2], h1;
            {
                const bool up = (lane & 32) != 0;
#pragma unroll
                for (int j = 0; j < 4; ++j) { const float mine = up ? g[4 + j] : g[j], send = up ? g[j] : g[4 + j]; h4[j] = mine + __shfl_xor(send, 32); }
            }
            {
                const bool up = (lane & 16) != 0;
#pragma unroll
                for (int j = 0; j < 2; ++j) { const float mine = up ? h4[2 + j] : h4[j], send = up ? h4[j] : h4[2 + j]; h2[j] = mine + __shfl_xor(send, 16); }
            }
            {
                const bool up = (lane & 8) != 0;
                const float mine = up ? h2[1] : h2[0], send = up ? h2[0] : h2[1];
                h1 = mine + __shfl_xor(send, 8);
            }
            h1 += __shfl_xor(h1, 4); h1 += __shfl_xor(h1, 2); h1 += __shfl_xor(h1, 1);
            if ((lane & 7) == 0) {
                const int gi = ((lane >> 5) & 1) * 4 + ((lane >> 4) & 1) * 2 + ((lane >> 3) & 1);
                const float pre = h1 * rstd + p.ab_if_bias[gi];
                if (gi < 4) LI[r * 4 + gi] = pre;
                else LF[r * 4 + gi - 4] = fminf(pre, 0.f) - log1pf(__expf(-fabsf(pre)));
            }
        }
    }
}

DI f32x4 mfma16(bf16x8 a, bf16x8 b, f32x4 c) { return __builtin_amdgcn_mfma_f32_16x16x32_bf16(a, b, c, 0, 0, 0); }
DI f32x16 mfma32(bf16x8 a, bf16x8 b, f32x16 c) { return __builtin_amdgcn_mfma_f32_32x32x16_bf16(a, b, c, 0, 0, 0); }

DI void mlstm_unit(const Params& p, unsigned char* smem, int unit) {
    const int tid = tid_fresh(), lane = tid & 63, wid = tid >> 6, fr = lane & 15, fq = lane >> 4;
    const int b = unit >> 4, h = (unit >> 2) & 3, sl = unit & 3;
    bf16_t* sQ = (bf16_t*)smem;
    bf16_t* sK = sQ + 64 * 264;
    bf16_t* sCb = sK + 64 * 264;
    bf16_t* sKwt = sCb + 64 * 264;
    bf16_t* sVt = sKwt + 256 * 72;
    bf16_t* sSd = sVt + 64 * 72;
    float* sN = (float*)(sSd + 64 * 72);
    float* gbuf = sN + 256;
    float* snq = gbuf + 2 * 336; float* srs = snq + 64;
    const bf16_t* T1 = (const bf16_t*)(p.ws + OFF_R2);
    bf16_t* OG = (bf16_t*)(p.ws + OFF_R3);
    const float* LI = (const float*)(p.ws + OFF_LI); const float* LF = (const float*)(p.ws + OFF_LF);
    float* HSS = (float*)(p.ws + OFF_HSS);

    f32x4 accC[2][4];
#pragma unroll
    for (int a = 0; a < 2; ++a)
#pragma unroll
        for (int v = 0; v < 4; ++v) accC[a][v] = (f32x4){0.f, 0.f, 0.f, 0.f};
    if (tid < 256) sN[tid] = 0.f;
    float m_prev = 0.f;
    const int ti = wid >> 1, pi = (wid & 1) * 2;

    u32x4 rq[4], rk[4], rv; float rli = 0.f, rlf = 0.f; u32x2 rog[2];
    auto issue_loads = [&](int c) __attribute__((always_inline)) {
        const int base = c == 0 ? MR : b * 4096 + (c - 1) * 64;
        const int nv = c == 0 ? 16 : 64;
#pragma unroll
        for (int i = 0; i < 4; ++i) {
            const int vid = tid + 512 * i, s = vid >> 5, kv = vid & 31;
            const size_t row = (size_t)(base + (s < nv ? s : nv - 1));
            rq[i] = *(const u32x4*)(T1 + row * 4096 + h * 256 + kv * 8);
            rk[i] = *(const u32x4*)(T1 + row * 4096 + 1024 + h * 256 + kv * 8);
        }
        {
            const int s = lane, vv = wid;
            const size_t row = (size_t)(base + (s < nv ? s : nv - 1));
            rv = *(const u32x4*)(T1 + row * 4096 + 2048 + h * 256 + sl * 64 + vv * 8);
        }
        if (wid == 0) {
            const bool ok = lane < nv;
            const int row = base + (ok ? lane : 0);
            rli = ok ? LI[row * 4 + h] : -1e30f;
            rlf = ok ? LF[row * 4 + h] : 0.f;
        }
        {
            const int t = ti * 16 + fr;
            const size_t row = (size_t)(base + (t < nv ? t : 0));
#pragma unroll
            for (int x = 0; x < 2; ++x) rog[x] = *(const u32x2*)(OG + row * 2048 + h * 256 + sl * 64 + (pi + x) * 16 + fq * 4);
        }
    };
    auto gate_scan = [&](float* gb) __attribute__((always_inline)) {
        const float bb = wave_scan_add(rlf);
        const float g = rli - bb;
        const float cm = wave_scan_max(g);
        const float Mt = fmaxf(m_prev, cm);
        const float M63 = __builtin_bit_cast(float, __builtin_amdgcn_readlane(__builtin_bit_cast(int, Mt), 63));
        const float b63 = __builtin_bit_cast(float, __builtin_amdgcn_readlane(__builtin_bit_cast(int, bb), 63));
        gb[lane] = g; gb[64 + lane] = Mt; gb[128 + lane] = __expf(m_prev - Mt); gb[192 + lane] = __expf(-(bb + Mt)); gb[256 + lane] = __expf(g - M63);
        if (lane == 0) gb[320] = __expf(m_prev - M63);
        m_prev = b63 + M63;
    };
    issue_loads(0);
    if (wid == 0) gate_scan(gbuf);
    __syncthreads();

    for (int c = 0; c < 65; ++c) {
        const int base = c == 0 ? MR : b * 4096 + (c - 1) * 64;
        const int nv = c == 0 ? 16 : 64;
        const bool wr_out = c > 0 || b == 0;
        const float* sg = gbuf + (c & 1) * 336; const float* sMt = sg + 64; const float* swp = sg + 128; const float* semt = sg + 192; const float* sws = sg + 256; const float* sdec = sg + 320;
#pragma unroll
        for (int a = 0; a < 2; ++a)
#pragma unroll
            for (int v = 0; v < 4; ++v) {
                u32x2 w; w.x = pk2(accC[a][v][0], accC[a][v][1]); w.y = pk2(accC[a][v][2], accC[a][v][3]);
                *(u32x2*)(sCb + (v * 16 + fr) * 264 + (2 * wid + a) * 16 + fq * 4) = w;
            }
#pragma unroll
        for (int i = 0; i < 4; ++i) {
            const int vid = tid + 512 * i, s = vid >> 5, kv = vid & 31;
            *(u32x4*)(sQ + s * 264 + kv * 8) = rq[i];
            *(u32x4*)(sK + s * 264 + kv * 8) = rk[i];
        }
        {
            const int s = lane, vv = wid;
            const unsigned wv[4] = {rv.x, rv.y, rv.z, rv.w};
#pragma unroll
            for (int e = 0; e < 4; ++e) {
                sVt[(vv * 8 + 2 * e) * 72 + s] = (bf16_t)(wv[e] & 0xffffu);
                sVt[(vv * 8 + 2 * e + 1) * 72 + s] = (bf16_t)(wv[e] >> 16);
            }
        }
        __syncthreads();
        const u32x2 og0 = rog[0], og1 = rog[1];
        if (c + 1 < 65) issue_loads(c + 1);
#pragma unroll
        for (int i = 0; i < 4; ++i) {
            const int task = tid + 512 * i, k = task & 255, s0 = (task >> 8) * 8;
            float v[8];
            const f32x4 wa = *(const f32x4*)(sws + s0), wb = *(const f32x4*)(sws + s0 + 4);
#pragma unroll
            for (int e = 0; e < 4; ++e) { v[e] = bf2f(sK[(s0 + e) * 264 + k]) * wa[e]; v[4 + e] = bf2f(sK[(s0 + 4 + e) * 264 + k]) * wb[e]; }
            u32x4 w; w.x = pk2(v[0], v[1]); w.y = pk2(v[2], v[3]); w.z = pk2(v[4], v[5]); w.w = pk2(v[6], v[7]);
            *(u32x4*)(sKwt + k * 72 + s0) = w;
        }
        f32x4 accH[2];
        {
            bf16x8 Bq[8];
#pragma unroll
            for (int ks = 0; ks < 8; ++ks) Bq[ks] = *(const bf16x8*)(sQ + (ti * 16 + fr) * 264 + ks * 32 + fq * 8);
            const int t = ti * 16 + fr;
            const float Mt_t = sMt[t];
#pragma unroll
            for (int x = 0; x < 2; ++x) {
                const int si = pi + x;
                if (si > ti) {
                    if (fq == 0) srs[si * 64 + t] = 0.f;
                    *(u32x2*)(sSd + t * 72 + si * 16 + fq * 4) = (u32x2){0u, 0u};
                    continue;
                }
                f32x4 aS = (f32x4){0.f, 0.f, 0.f, 0.f};
#pragma unroll
                for (int ks = 0; ks < 8; ++ks) aS = mfma16(*(const bf16x8*)(sK + (si * 16 + fr) * 264 + ks * 32 + fq * 8), Bq[ks], aS);
                float val[4]; float ps = 0.f;
                const f32x4 gv = *(const f32x4*)(sg + si * 16 + fq * 4);
#pragma unroll
                for (int j = 0; j < 4; ++j) {
                    const int s = si * 16 + fq * 4 + j;
                    const float e = __expf(fminf(gv[j] - Mt_t, 0.f));
                    const float d = (s <= t) ? e : 0.f;
                    val[j] = aS[j] * d; ps += val[j];
                }
                ps = sum_x16_x32(ps);
                if (fq == 0) srs[si * 64 + t] = ps;
                u32x2 w; w.x = pk2(val[0], val[1]); w.y = pk2(val[2], val[3]);
                *(u32x2*)(sSd + t * 72 + si * 16 + fq * 4) = w;
            }
#pragma unroll
            for (int x = 0; x < 2; ++x) {
                const int vi = pi + x;
                f32x4 aH = (f32x4){0.f, 0.f, 0.f, 0.f};
#pragma unroll
                for (int ks = 0; ks < 8; ++ks) aH = mfma16(*(const bf16x8*)(sCb + (vi * 16 + fr) * 264 + ks * 32 + fq * 8), Bq[ks], aH);
                accH[x] = aH;
            }
        }
        {
            const int t = tid >> 3, part = tid & 7;
            float s = 0.f;
#pragma unroll
            for (int i = 0; i < 4; ++i) {
                const u32x4 qv = *(const u32x4*)(sQ + t * 264 + part * 32 + i * 8);
                const f32x4 na = *(const f32x4*)(sN + part * 32 + i * 8), nb = *(const f32x4*)(sN + part * 32 + i * 8 + 4);
                s += bflo(qv.x) * na[0] + bfhi(qv.x) * na[1] + bflo(qv.y) * na[2] + bfhi(qv.y) * na[3]
                   + bflo(qv.z) * nb[0] + bfhi(qv.z) * nb[1] + bflo(qv.w) * nb[2] + bfhi(qv.w) * nb[3];
            }
            s += __shfl_xor(s, 1); s += __shfl_xor(s, 2); s += __shfl_xor(s, 4);
            if (part == 0) snq[t] = s;
        }
        __syncthreads();
        {
            const int t = ti * 16 + fr;
            const float wp = swp[t];
            const float den = wp * snq[t] + (srs[t] + srs[64 + t]) + (srs[128 + t] + srs[192 + t]);
            const float inv = __builtin_amdgcn_rcpf(fmaxf(fabsf(den), semt[t]));
            const bool ok = t < nv && wr_out;
            const size_t row = (size_t)(base + (ok ? t : 0));
            float sq = 0.f;
#pragma unroll
            for (int x = 0; x < 2; ++x) {
                const int vi = pi + x;
                f32x4 a = accH[x] * wp;
#pragma unroll
                for (int k2 = 0; k2 < 2; ++k2)
                    a = mfma16(*(const bf16x8*)(sVt + (vi * 16 + fr) * 72 + k2 * 32 + fq * 8), *(const bf16x8*)(sSd + t * 72 + k2 * 32 + fq * 8), a);
                bf16_t* op = OG + row * 2048 + h * 256 + sl * 64 + vi * 16 + fq * 4;
                if (ok) {
                    const u32x2 ov = x == 0 ? og0 : og1;
                    const float h0 = a[0] * inv * bflo(ov.x), h1 = a[1] * inv * bfhi(ov.x), h2 = a[2] * inv * bflo(ov.y), h3 = a[3] * inv * bfhi(ov.y);
                    u32x2 w; w.x = pk2(h0, h1); w.y = pk2(h2, h3);
                    *(u32x2*)op = w;
                    sq += h0 * h0 + h1 * h1 + h2 * h2 + h3 * h3;
                }
            }
            sq = sum_x16_x32(sq);
            if (fq == 0 && ok) atomicAdd(HSS + row * 4 + h, sq);
        }
        {
            const float dec = sdec[0];
            bf16x8 Bv[4][2];
#pragma unroll
            for (int v = 0; v < 4; ++v)
#pragma unroll
                for (int k2 = 0; k2 < 2; ++k2) Bv[v][k2] = *(const bf16x8*)(sVt + (v * 16 + fr) * 72 + k2 * 32 + fq * 8);
#pragma unroll
            for (int a = 0; a < 2; ++a) {
                bf16x8 Ak[2];
#pragma unroll
                for (int k2 = 0; k2 < 2; ++k2) Ak[k2] = *(const bf16x8*)(sKwt + ((2 * wid + a) * 16 + fr) * 72 + k2 * 32 + fq * 8);
#pragma unroll
                for (int v = 0; v < 4; ++v) {
                    f32x4 acc = accC[a][v] * dec;
                    acc = mfma16(Ak[0], Bv[v][0], acc);
                    acc = mfma16(Ak[1], Bv[v][1], acc);
                    accC[a][v] = acc;
                }
            }
            if (tid < 256) {
                float s = 0.f;
#pragma unroll
                for (int i = 0; i < 8; ++i) {
                    const u32x4 kv = *(const u32x4*)(sKwt + tid * 72 + i * 8);
                    s += (bflo(kv.x) + bfhi(kv.x)) + (bflo(kv.y) + bfhi(kv.y)) + (bflo(kv.z) + bfhi(kv.z)) + (bflo(kv.w) + bfhi(kv.w));
                }
                sN[tid] = dec * sN[tid] + s;
            }
        }
        if (wid == 0 && c + 1 < 65) gate_scan(gbuf + ((c + 1) & 1) * 336);
        __syncthreads();
    }
}

DI void lru_unit(const Params& p, unsigned char* smem, int unit) {
    const int tid = tid_fresh(), lane = tid & 63, wid = tid >> 6, fr = lane & 15, fq = lane >> 4;
    const int b = unit >> 4, n = (unit >> 1) & 7, half = unit & 1;
    bf16_t* sW = (bf16_t*)smem;
    bf16_t* sRaw = sW + 128 * 136;
    bf16_t* sXc = sRaw + 68 * 128;
    float* sXf = (float*)(sXc + 64 * 136);
    float* sA = sXf + 64 * 64;
    float* sU = sA + 64 * 65;
    const bf16_t* T1 = (const bf16_t*)(p.ws + OFF_R2);
    bf16_t* OG = (bf16_t*)(p.ws + OFF_R3);
    const bf16_t* WL = (const bf16_t*)(p.ws + OFF_WLRU);
#pragma unroll
    for (int i = 0; i < 4; ++i) {
        const int vid = tid + 512 * i, rr = vid >> 4, part = vid & 15;
        const int which = rr >> 6, e = half * 64 + (rr & 63);
        *(u32x4*)(sW + rr * 136 + part * 8) = *(const u32x4*)(WL + ((size_t)((n * 2 + which) * 128 + e)) * 128 + part * 8);
    }
    const int d8 = tid & 15, tq = tid >> 4;
    float cw[4][8], cb[8];
#pragma unroll
    for (int e = 0; e < 8; ++e) {
        const int ch = n * 128 + d8 * 8 + e;
        cb[e] = p.conv_b[ch];
#pragma unroll
        for (int j = 0; j < 4; ++j) cw[j][e] = p.conv_w[j * 1024 + ch];
    }
    const int et = wid & 3;
    float br[4], bi[4], sp[4];
#pragma unroll
    for (int j = 0; j < 4; ++j) {
        const int ch = n * 128 + half * 64 + et * 16 + fq * 4 + j;
        br[j] = p.b_r[ch]; bi[j] = p.b_i[ch];
        const float l = p.lam[ch];
        sp[j] = fmaxf(-l, 0.f) + log1pf(__expf(-fabsf(l)));
    }
    float hstate = 0.f;

    u32x4 rr_[3], rg_;
    auto issue_loads = [&](int c) __attribute__((always_inline)) {
        const int t0 = c == 0 ? 0 : 16 + (c - 1) * 64;
        {
            const int t = tid >> 3, nvc = c == 0 ? 16 : 64;
            const size_t row = (size_t)((c == 0 ? MR : b * 4096 + (c - 1) * 64) + (t < nvc ? t : 0));
            rg_ = *(const u32x4*)(OG + row * 2048 + 1024 + n * 128 + half * 64 + (tid & 7) * 8);
        }
#pragma unroll
        for (int i = 0; i < 3; ++i) {
            const int vid = tid + 512 * i, ri = vid >> 4, part = vid & 15;
            const int tt = t0 - 3 + ri;
            u32x4 v = (u32x4){0u, 0u, 0u, 0u};
            if (ri < 67 && tt >= 0 && tt < TSEQ) {
                const size_t row = tt < 16 ? (size_t)(MR + tt) : (size_t)(b * 4096 + tt - 16);
                v = *(const u32x4*)(T1 + row * 4096 + 3072 + n * 128 + part * 8);
            }
            rr_[i] = v;
        }
    };
    issue_loads(0);
    __syncthreads();
    for (int c = 0; c < 65; ++c) {
        const int base = c == 0 ? MR : b * 4096 + (c - 1) * 64;
        const int nv = c == 0 ? 16 : 64;
#pragma unroll
        for (int i = 0; i < 3; ++i) {
            const int vid = tid + 512 * i, ri = vid >> 4, part = vid & 15;
            if (ri < 67) *(u32x4*)(sRaw + ri * 128 + part * 8) = rr_[i];
        }
        __syncthreads();
        const u32x4 gv = rg_;
        if (c + 1 < 65) issue_loads(c + 1);
        {
            float x[5][8];
#pragma unroll
            for (int r = 0; r < 5; ++r) {
                const u32x4 v = *(const u32x4*)(sRaw + (2 * tq + r) * 128 + d8 * 8);
                x[r][0] = bflo(v.x); x[r][1] = bfhi(v.x); x[r][2] = bflo(v.y); x[r][3] = bfhi(v.y);
                x[r][4] = bflo(v.z); x[r][5] = bfhi(v.z); x[r][6] = bflo(v.w); x[r][7] = bfhi(v.w);
            }
#pragma unroll
            for (int tt = 0; tt < 2; ++tt) {
                const int t = 2 * tq + tt;
                float o[8];
#pragma unroll
                for (int e = 0; e < 8; ++e) o[e] = cb[e] + cw[0][e] * x[tt][e] + cw[1][e] * x[tt + 1][e] + cw[2][e] * x[tt + 2][e] + cw[3][e] * x[tt + 3][e];
                u32x4 w; w.x = pk2(o[0], o[1]); w.y = pk2(o[2], o[3]); w.z = pk2(o[4], o[5]); w.w = pk2(o[6], o[7]);
                *(u32x4*)(sXc + t * 136 + d8 * 8) = w;
                if ((d8 >> 3) == half) {
                    float* xf = sXf + t * 64 + (d8 & 7) * 8;
                    *(f32x4*)xf = (f32x4){o[0], o[1], o[2], o[3]};
                    *(f32x4*)(xf + 4) = (f32x4){o[4], o[5], o[6], o[7]};
                }
            }
        }
        __syncthreads();
        {
            bf16x8 Ar[4], Ai[4];
#pragma unroll
            for (int ks = 0; ks < 4; ++ks) {
                Ar[ks] = *(const bf16x8*)(sW + (et * 16 + fr) * 136 + ks * 32 + fq * 8);
                Ai[ks] = *(const bf16x8*)(sW + (64 + et * 16 + fr) * 136 + ks * 32 + fq * 8);
            }
#pragma unroll
            for (int x = 0; x < 2; ++x) {
                const int t = ((wid >> 2) * 2 + x) * 16 + fr;
                f32x4 aR = (f32x4){0.f, 0.f, 0.f, 0.f}, aI = (f32x4){0.f, 0.f, 0.f, 0.f};
#pragma unroll
                for (int ks = 0; ks < 4; ++ks) {
                    const bf16x8 Bx = *(const bf16x8*)(sXc + t * 136 + ks * 32 + fq * 8);
                    aR = mfma16(Ar[ks], Bx, aR);
                    aI = mfma16(Ai[ks], Bx, aI);
                }
                const f32x4 xv = *(const f32x4*)(sXf + t * 64 + et * 16 + fq * 4);
#pragma unroll
                for (int j = 0; j < 4; ++j) {
                    const float r = sigmoidf_(aR[j] + br[j]), ig = sigmoidf_(aI[j] + bi[j]);
                    const float la = -8.0f * r * sp[j];
                    const float a = __expf(la);
                    const float u = sqrtf(fmaxf(-expm1f(2.0f * la), 0.f)) * (ig * xv[j]);
                    sA[t * 65 + et * 16 + fq * 4 + j] = a;
                    sU[t * 65 + et * 16 + fq * 4 + j] = u;
                }
            }
        }
        __syncthreads();
        if (wid == 0) {
            float hs = hstate;
            for (int t0 = 0; t0 < nv; t0 += 16) {
                float av[16], uv[16];
#pragma unroll
                for (int i = 0; i < 16; ++i) { av[i] = sA[(t0 + i) * 65 + lane]; uv[i] = sU[(t0 + i) * 65 + lane]; }
#pragma unroll
                for (int i = 0; i < 16; ++i) { hs = av[i] * hs + uv[i]; uv[i] = hs; }
#pragma unroll
                for (int i = 0; i < 16; ++i) sU[(t0 + i) * 65 + lane] = uv[i];
            }
            hstate = hs;
        }
        __syncthreads();
        {
            const int t = tid >> 3, e0 = (tid & 7) * 8;
            if (t < nv && (c > 0 || b == 0)) {
                bf16_t* op = OG + (size_t)(base + t) * 2048 + 1024 + n * 128 + half * 64 + e0;
                const float* hp = sU + t * 65 + e0;
                u32x4 w;
                w.x = pk2(hp[0] * bflo(gv.x), hp[1] * bfhi(gv.x)); w.y = pk2(hp[2] * bflo(gv.y), hp[3] * bfhi(gv.y));
                w.z = pk2(hp[4] * bflo(gv.z), hp[5] * bfhi(gv.z)); w.w = pk2(hp[6] * bflo(gv.w), hp[7] * bfhi(gv.w));
                *(u32x4*)op = w;
            }
        }
    }
    __syncthreads();
}

DI void mixer0_phase(const Params& p, unsigned char* smem, int mask = 3, bool conv = true) {
    for (int w = blockIdx.x; w < 256; w += gridDim.x) {
        if (w < 128) { if (mask & 1) mlstm_unit(p, smem, w); } else { if (mask & 2) lru_unit(p, smem, w - 128); }
        __syncthreads();
    }
    const int half = gridDim.x >> 1;
    if (conv && (int)blockIdx.x >= half) wt_convert(p, smem, 1, 8, blockIdx.x - half, gridDim.x - half);
}

DI void headnorm_phase(const Params& p) {
    const int tid = tid_fresh(), lane = tid & 63, wid = tid >> 6;
    bf16_t* OG = (bf16_t*)(p.ws + OFF_R3);
    const float* HSS = (const float*)(p.ws + OFF_HSS);
    for (int r = blockIdx.x * 8 + wid; r < MR + 16; r += gridDim.x * 8) {
        const float sc = rsqrtf(HSS[r * 4 + (lane >> 4)] * (1.0f / 256.0f) + EPS);
        bf16_t* op = OG + (size_t)r * 2048 + lane * 16;
#pragma unroll
        for (int i = 0; i < 2; ++i) {
            const u32x4 v = *(const u32x4*)(op + i * 8);
            u32x4 w;
            w.x = pk2(bflo(v.x) * sc, bfhi(v.x) * sc); w.y = pk2(bflo(v.y) * sc, bfhi(v.y) * sc);
            w.z = pk2(bflo(v.z) * sc, bfhi(v.z) * sc); w.w = pk2(bflo(v.w) * sc, bfhi(v.w) * sc);
            *(u32x4*)(op + i * 8) = w;
        }
    }
}

DI bf16x8 pack8(const f32x16& x, int s) {
    u32x4 w; w.x = pk2(x[8 * s], x[8 * s + 1]); w.y = pk2(x[8 * s + 2], x[8 * s + 3]); w.z = pk2(x[8 * s + 4], x[8 * s + 5]); w.w = pk2(x[8 * s + 6], x[8 * s + 7]);
    return __builtin_bit_cast(bf16x8, w);
}
DI void attn_phase(const Params& p, unsigned char* smem) {
    const int tid = tid_fresh(), lane = tid & 63, wid = tid >> 6, l31 = lane & 31, hi = lane >> 5;
    const int comp = wid & 1, qg = wid >> 1;
    LAS unsigned char* lds = (LAS unsigned char*)smem;
    bf16_t* sK = (bf16_t*)smem;
    bf16_t* sV = sK + 2 * 64 * 128;
    float* sO = (float*)smem;
    const bf16_t* QK = (const bf16_t*)(p.ws + OFF_QK1);
    const bf16_t* VT = (const bf16_t*)(p.ws + OFF_VT);
    bf16_t* AO = (bf16_t*)(p.ws + OFF_AO);
    const float lam = __builtin_bit_cast(float, __builtin_amdgcn_readfirstlane(((const int*)(p.ws + OFF_MISC))[0]));
    const int wu = __builtin_amdgcn_readfirstlane(wid);
    for (int unit = blockIdx.x; unit < 2048; unit += gridDim.x) {
        const int round = unit >> 8, i256 = unit & 255, bh = i256 >> 2, jj = i256 & 3;
        const int qb = (round & 1) ? 24 - 8 * (round >> 1) + jj : 31 - 8 * (round >> 1) - jj;
        const int b = bh >> 3, head = bh & 7;
        const int q0 = qb * 128 + qg * 32;
        bf16x8 Qf[4];
#pragma unroll
        for (int ks = 0; ks < 4; ++ks) Qf[ks] = *(const bf16x8*)(QK + (size_t)(b * 4096 + q0 + l31) * 2048 + head * 128 + comp * 64 + ks * 16 + hi * 8);
        f32x16 O[4];
#pragma unroll
        for (int d = 0; d < 4; ++d)
#pragma unroll
            for (int i = 0; i < 16; ++i) O[d][i] = 0.f;
        float mrun = 0.f, lrun = 0.f;
        f32x16 NEGM;
#pragma unroll
        for (int i = 0; i < 16; ++i) NEGM[i] = 0.f;
        const int ntile = 2 * (qb + 1) + 1;

        auto dma_tile = [&](int j, int buf) __attribute__((always_inline)) {
            const size_t krow0 = j == 0 ? (size_t)MR : (size_t)(b * 4096 + (j - 1) * 64);
#pragma unroll
            for (int i = 0; i < 2; ++i) {
                const int bi = wu * 2 + i;
                {
                    const int key = 4 * bi + (lane >> 4), part = (lane & 15) ^ (key & 15);
                    __builtin_amdgcn_global_load_lds((const unsigned*)(QK + (krow0 + key) * 2048 + 1024 + head * 128 + part * 8),
                                                     (LAS unsigned*)(lds + buf * 16384 + bi * 1024), 16, 0, 0);
                }
                {
                    const int dv = 8 * bi + (lane >> 3), ch = (lane & 7) ^ ((dv >> 1) & 7);
                    __builtin_amdgcn_global_load_lds((const unsigned*)(VT + (size_t)(head * 128 + dv) * MP + krow0 + ch * 8),
                                                     (LAS unsigned*)(lds + 32768 + buf * 16384 + bi * 1024), 16, 0, 0);
                }
            }
        };
        auto qk_half = [&](const bf16_t* kb, int kh, int ksw) __attribute__((always_inline)) {
            f32x16 S = NEGM;
#pragma unroll
            for (int ks = 0; ks < 4; ++ks)
                S = mfma32(*(const bf16x8*)(kb + (kh * 32 + l31) * 128 + (((comp * 8 + ks * 2 + hi) ^ ksw) * 8)), Qf[ks], S);
            return S;
        };
        auto softmax_half = [&](f32x16& S, f32x16* Spend, int j, int kh, int kbase, bool need_mask, bf16x8 (&P)[2]) __attribute__((always_inline)) {
            if (need_mask) {
#pragma unroll
                for (int i = 0; i < 16; ++i) {
                    const int key = kh * 32 + 8 * (i >> 2) + 4 * hi + (i & 3);
                    const bool vis = (j == 0) ? (key < 16) : (kbase + key <= q0 + l31);
                    if (!vis) S[i] = -INFINITY;
                }
            }
            float mx = S[0];
#pragma unroll
            for (int i = 1; i < 16; ++i) mx = fmaxf(mx, S[i]);
            mx = max_x32(mx);
            if (__any(mx > 8.0f)) {
                const float dm = fmaxf(mx, 0.f);
                const float alpha = __builtin_amdgcn_exp2f(-dm);
                mrun += dm;
                lrun *= alpha;
#pragma unroll
                for (int d = 0; d < 4; ++d) O[d] = O[d] * alpha;
#pragma unroll
                for (int i = 0; i < 16; ++i) { S[i] -= dm; NEGM[i] = -mrun; }
                if (Spend) {
#pragma unroll
                    for (int i = 0; i < 16; ++i) (*Spend)[i] -= dm;
                }
            }
            float ls = 0.f;
#pragma unroll
            for (int i = 0; i < 16; ++i) { const float e = __builtin_amdgcn_exp2f(S[i]); S[i] = e; ls += e; }
            lrun += ls;
            P[0] = pack8(S, 0); P[1] = pack8(S, 1);
        };
        auto pv_half = [&](const bf16_t* vb, int kh, int dsw, const bf16x8 (&P)[2]) __attribute__((always_inline)) {
#pragma unroll
            for (int s2 = 0; s2 < 2; ++s2) {
                const int u = kh * 2 + s2;
#pragma unroll
                for (int d = 0; d < 4; ++d) {
                    const bf16x8 A = *(const bf16x8*)(vb + (d * 32 + l31) * 64 + (((2 * u + hi) ^ dsw) * 8));
                    O[d] = mfma32(A, P[s2], O[d]);
                }
            }
        };

        __syncthreads();
        dma_tile(0, 0);
        asm volatile("s_waitcnt vmcnt(0)" ::: "memory");
        __syncthreads();
        for (int j = 0; j < ntile; ++j) {
            const int buf = j & 1;
            if (j + 1 < ntile) dma_tile(j + 1, buf ^ 1);
            const int kbase = (j - 1) * 64;
            const bool active = (j == 0) || (kbase <= q0 + 31);
            if (active) {
                const bf16_t* kb = sK + buf * 64 * 128;
                const bf16_t* vb = sV + buf * 128 * 64;
                const bool need_mask = (j == 0) || (kbase + 63 > q0);
                const bool act1 = (j >= 1) && (kbase + 32 <= q0 + 31);
                const int ksw = l31 & 15, dsw = (l31 >> 1) & 7;
                f32x16 S0 = qk_half(kb, 0, ksw);
                bf16x8 P[2];
                if (act1) {
                    f32x16 S1 = qk_half(kb, 1, ksw);
                    softmax_half(S0, &S1, j, 0, kbase, need_mask, P);
                    pv_half(vb, 0, dsw, P);
                    softmax_half(S1, nullptr, j, 1, kbase, need_mask, P);
                    pv_half(vb, 1, dsw, P);
                } else {
                    softmax_half(S0, nullptr, j, 0, kbase, need_mask, P);
                    pv_half(vb, 0, dsw, P);
                }
            }
            asm volatile("s_waitcnt vmcnt(0)" ::: "memory");
            __syncthreads();
        }
        {
            const float l = sum_x32(lrun);
            float* so = sO + qg * 4096 + lane;
            if (comp == 1) {
                const float sc1 = lam / l;
#pragma unroll
                for (int d = 0; d < 4; ++d)
#pragma unroll
                    for (int i = 0; i < 16; ++i) so[(d * 16 + i) * 64] = O[d][i] * sc1;
            }
            __syncthreads();
            if (comp == 0) {
                const float i0 = 1.0f / l;
                float sq = 0.f;
#pragma unroll
                for (int d = 0; d < 4; ++d)
#pragma unroll
                    for (int i = 0; i < 16; ++i) { const float o = O[d][i] * i0 - so[(d * 16 + i) * 64]; O[d][i] = o; sq += o * o; }
                sq = sum_x32(sq);
                const float sc = rsqrtf(sq * (1.0f / 128.0f) + EPS);
                bf16_t* op = AO + (size_t)(b * 4096 + q0 + l31) * 1024 + head * 128;
#pragma unroll
                for (int d = 0; d < 4; ++d)
#pragma unroll
                    for (int g = 0; g < 4; ++g) {
                        u32x2 w; w.x = pk2(O[d][4 * g] * sc, O[d][4 * g + 1] * sc); w.y = pk2(O[d][4 * g + 2] * sc, O[d][4 * g + 3] * sc);
                        *(u32x2*)(op + d * 32 + 8 * g + 4 * hi) = w;
                    }
            }
        }
    }
}

DI void final_phase(const Params& p) {
    const int tid = tid_fresh(), lane = tid & 63, wid = tid >> 6;
    const float* h = (const float*)(p.ws + OFF_H);
    const float* ss = (const float*)(p.ws + OFF_SS) + 3 * MP;
    for (int r = blockIdx.x * 8 + wid; r < MR; r += gridDim.x * 8) {
        const float rstd = rsqrtf(ss[r] * (1.0f / 1024.0f) + EPS);
#pragma unroll
        for (int i = 0; i < 4; ++i) {
            const int c = i * 256 + lane * 4;
            const f32x4 v = *(const f32x4*)(h + (size_t)r * 1024 + c);
            const f32x4 g = *(const f32x4*)(p.norm_final + c);
            *(f32x4*)(p.out + (size_t)r * 1024 + c) = v * rstd * g;
        }
    }
}

template <class Epi> DI void small_gemm(const bf16_t* A, const bf16_t* Bt, int N, int K, const Epi& E) {
    const int tid = tid_fresh(), lane = tid & 63, wid = tid >> 6, fr = lane & 15, fq = lane >> 4;
    const int nw = gridDim.x * 8;
    for (int tile = blockIdx.x * 8 + wid; tile < (N >> 4); tile += nw) {
        const int n0 = tile * 16;
        f32x4 acc = (f32x4){0.f, 0.f, 0.f, 0.f};
        const bf16_t* ap = A + (size_t)fr * K + fq * 8;
        const bf16_t* bp = Bt + (size_t)(n0 + fr) * K + fq * 8;
#pragma unroll 16
        for (int k = 0; k < K; k += 32) acc = mfma16(*(const bf16x8*)(bp + k), *(const bf16x8*)(ap + k), acc);
        E(acc, fr, n0 + fq * 4, fq);
    }
}
struct SEpiIn0 {
    bf16_t* T1; bf16_t* OG;
    DI void operator()(f32x4 v, int row, int n, int fq) const {
        bf16_t* dst;
        if (n < 4096) dst = T1 + (size_t)(MR + row) * 4096 + n;
        else {
            dst = OG + (size_t)(MR + row) * 2048 + (n - 4096);
            if (n < 5120) {
#pragma unroll
                for (int j = 0; j < 4; ++j) v[j] = sigmoidf_(v[j]);
            } else {
#pragma unroll
                for (int j = 0; j < 4; ++j) v[j] = gelu_tanh(v[j]);
            }
        }
        u32x2 w; w.x = pk2(v[0], v[1]); w.y = pk2(v[2], v[3]);
        *(u32x2*)dst = w;
    }
};
template <int MODE> struct SEpiRes {
    float* h; bf16_t* hb; float* ss; const float* meta;
    DI void operator()(f32x4 acc, int row, int n, int fq) const {
        const size_t r = (size_t)(MR + row);
        const f32x4 rv = MODE == 0 ? *(const f32x4*)(meta + (size_t)row * 1024 + n) : *(const f32x4*)(h + r * 1024 + n);
        const f32x4 v = acc + rv;
        *(f32x4*)(h + r * 1024 + n) = v;
        u32x2 w; w.x = pk2(v[0], v[1]); w.y = pk2(v[2], v[3]);
        *(u32x2*)(hb + r * 1024 + n) = w;
        float sq = v[0] * v[0] + v[1] * v[1] + v[2] * v[2] + v[3] * v[3];
        sq = sum_x16_x32(sq);
        if (fq == 0) atomicAdd(ss + r, sq);
    }
};
struct SEpiUp {
    bf16_t* HID; const float* ss;
    DI void operator()(f32x4 v, int row, int n, int fq) const {
        const size_t r = (size_t)(MR + row);
        const float rstd = rsqrtf(ss[r] * (1.0f / 1024.0f) + EPS);
#pragma unroll
        for (int j = 0; j < 4; ++j) { const float a = fmaxf(v[j] * rstd, 0.f); v[j] = a * a; }
        u32x2 w; w.x = pk2(v[0], v[1]); w.y = pk2(v[2], v[3]);
        *(u32x2*)(HID + r * 4096 + n) = w;
    }
};
struct SEpiQKV {
    bf16_t* QK; bf16_t* VT; const float* ss; const float* rope;
    DI void operator()(f32x4 v, int row, int n, int fq) const {
        const size_t r = (size_t)(MR + row);
        const float rstd = rsqrtf(ss[r] * (1.0f / 1024.0f) + EPS);
#pragma unroll
        for (int j = 0; j < 4; ++j) v[j] *= rstd;
        if (n < 2048) {
            if (((n - fq * 4) & 63) == 0) {
                const f32x4 cs = *(const f32x4*)(rope + row * 16 + (fq & 1) * 4), sn = *(const f32x4*)(rope + row * 16 + 8 + (fq & 1) * 4);
#pragma unroll
                for (int j = 0; j < 4; ++j) {
                    const float other = __shfl_xor(v[j], 32);
                    v[j] = fq < 2 ? v[j] * cs[j] - other * sn[j] : v[j] * cs[j] + other * sn[j];
                }
            }
            u32x2 w; w.x = pk2(v[0], v[1]); w.y = pk2(v[2], v[3]);
            *(u32x2*)(QK + r * 2048 + n) = w;
        } else {
#pragma unroll
            for (int j = 0; j < 4; ++j) VT[(size_t)(n - 2048 + j) * MP + MR + ((row & 3) | ((row & 4) << 1) | ((row & 8) >> 1))] = f2bf(v[j]);
        }
    }
};

#define XB_TMO      128
#define XB_XCNT(j)  (256  + 64 * (j))
#define XB_XSUB(j)  (1280 + 64 * (j))
#define XB_XGEN(j)  (2304 + 64 * (j))
#define XB_TOP      3328
#define XB_TOPGEN   3392
#define XCD_BAR_WORDS 3456
#define XB_SPIN_CAP (1u << 18)
DI unsigned xb_ld(unsigned* p)              { return __hip_atomic_load(p, __ATOMIC_RELAXED, __HIP_MEMORY_SCOPE_AGENT); }
DI unsigned xb_add(unsigned* p, unsigned v) { return __hip_atomic_fetch_add(p, v, __ATOMIC_RELAXED, __HIP_MEMORY_SCOPE_AGENT); }
DI unsigned xb_xcc_id() { return (unsigned)__builtin_amdgcn_s_getreg((3 << 11) | 20) & 0xFu; }
#define XB_SPIN(cond, bar) do { unsigned _sp = 0; while (cond) { __builtin_amdgcn_s_sleep(1); \
    if ((++_sp & 255u) == 0u) { if (xb_ld(&(bar)[XB_TMO])) break; if (_sp > XB_SPIN_CAP) { atomicAdd(&(bar)[XB_TMO], 1u); break; } } } } while (0)
struct XcdBarrier { unsigned* bar; unsigned x; volatile LAS unsigned* st; };
DI XcdBarrier xcd_barrier_post(unsigned* bar, volatile LAS unsigned* st) {
    XcdBarrier b; b.bar = bar; b.x = xb_xcc_id(); b.st = st;
    if (threadIdx.x == 0) (void)xb_add(&bar[XB_XCNT(b.x)], 1u);
    return b;
}
DI void xcd_barrier_complete(unsigned* bar, unsigned x, unsigned& nloc, unsigned& nx) {
    const unsigned G = gridDim.x * gridDim.y * gridDim.z;
    unsigned sum, cnt, mine, sp = 0u;
    for (;;) {
        sum = 0u; cnt = 0u; mine = 0u;
#pragma unroll
        for (unsigned j = 0; j < 16; ++j) { const unsigned c = xb_ld(&bar[XB_XCNT(j)]); sum += c; cnt += (c > 0u) ? 1u : 0u; mine = (j == x) ? c : mine; }
        if (sum == G) break;
        __builtin_amdgcn_s_sleep(1);
        if ((++sp & 255u) == 0u) { if (xb_ld(&bar[XB_TMO])) break; if (sp > XB_SPIN_CAP) { atomicAdd(&bar[XB_TMO], 1u); break; } }
    }
    nloc = mine > 0u ? mine : 1u; nx = cnt > 0u ? cnt : 1u;
}
DI void xcd_barrier(const XcdBarrier& b) {
    asm volatile("s_waitcnt vmcnt(0)" ::: "memory");
    __syncthreads();
    if (threadIdx.x == 0) {
        unsigned* bar = b.bar;
        __builtin_amdgcn_s_waitcnt(0);
        unsigned nloc = b.st[0], nx = b.st[1];
        if (nloc == 0u) { xcd_barrier_complete(bar, b.x, nloc, nx); b.st[0] = nloc; b.st[1] = nx; }
        const unsigned old = xb_add(&bar[XB_XSUB(b.x)], 1u);
        const unsigned gen = old / nloc;
        if (old + 1u == (gen + 1u) * nloc) {
            __builtin_amdgcn_fence(__ATOMIC_RELEASE, "agent");
            asm volatile("s_waitcnt vmcnt(0)" ::: "memory");
            const unsigned og = xb_add(&bar[XB_TOP], 1u);
            const unsigned tg = og / nx;
            if (og + 1u == (tg + 1u) * nx) xb_add(&bar[XB_TOPGEN], 1u);
            else XB_SPIN(xb_ld(&bar[XB_TOPGEN]) == tg, bar);
            __builtin_amdgcn_fence(__ATOMIC_ACQUIRE, "agent");
            xb_add(&bar[XB_XGEN(b.x)], 1u);
            asm volatile("s_waitcnt vmcnt(0)" ::: "memory");
        } else {
            XB_SPIN(xb_ld(&bar[XB_XGEN(b.x)]) == gen, bar);
            __builtin_amdgcn_fence(__ATOMIC_ACQUIRE, "agent");
            asm volatile("s_waitcnt vmcnt(0)" ::: "memory");
        }
    }
    __syncthreads();
}

#ifndef DUP
#define DUP 0
#endif
__global__ void __launch_bounds__(512) fwd_megakernel(Params p) {
    extern __shared__ __attribute__((aligned(16))) unsigned char smem[];
    cg::grid_group grid = cg::this_grid();
    LAS unsigned char* lds = (LAS unsigned char*)smem;
    const int G = gridDim.x, c = blockIdx.x;
    bf16_t* HB = (bf16_t*)(p.ws + OFF_HB);
    float* H = (float*)(p.ws + OFF_H);
    float* SS = (float*)(p.ws + OFF_SS);
    bf16_t* HID = (bf16_t*)(p.ws + OFF_HID);
    pg8::StaticOrder S;

    unsigned* bar = (unsigned*)(p.ws + OFF_BAR);
    volatile LAS unsigned* xst = (volatile LAS unsigned*)(lds + LDS_BYTES - 16);
    if (threadIdx.x == 0) { xst[0] = 0u; xst[1] = 0u; }
    __syncthreads();
    const XcdBarrier xb = xcd_barrier_post(bar, xst);
    if (p.out == nullptr) grid.sync();
    prologue_phase(p, smem);
    xcd_barrier(xb);
#if DUP == 4
    prologue_phase(p, smem);
    xcd_barrier(xb);
#endif
    {
        pg8::Gemm g{HB, (const bf16_t*)(p.ws + OFF_WIN0), MR, 6144, 1024};
        EpiIn0 E{(bf16_t*)(p.ws + OFF_R2), (bf16_t*)(p.ws + OFF_R3)};
        SEpiIn0 Es{(bf16_t*)(p.ws + OFF_R2), (bf16_t*)(p.ws + OFF_R3)};
        small_gemm(HB + (size_t)MR * 1024, g.Bt, 6144, 1024, Es);
        S.init(MR, 6144, G, c); pg8::gemm_phase(lds, g, S, E);
    }
    xcd_barrier(xb);
    mixer0_phase(p, smem);
    xcd_barrier(xb);
#if DUP == 2
    {
        pg8::Gemm g{HB, (const bf16_t*)(p.ws + OFF_WIN0), MR, 6144, 1024};
        EpiIn0 E{(bf16_t*)(p.ws + OFF_R2), (bf16_t*)(p.ws + OFF_R3)};
        SEpiIn0 Es{(bf16_t*)(p.ws + OFF_R2), (bf16_t*)(p.ws + OFF_R3)};
        small_gemm(HB + (size_t)MR * 1024, g.Bt, 6144, 1024, Es);
        S.init(MR, 6144, G, c); pg8::gemm_phase(lds, g, S, E);
        float* z = (float*)(p.ws + OFF_HSS);
        for (int i = blockIdx.x * 512 + threadIdx.x; i < 4 * MP; i += gridDim.x * 512) z[i] = 0.f;
    }
    xcd_barrier(xb);
    mixer0_phase(p, smem);
    xcd_barrier(xb);
#endif
#if DUP == 6 || DUP == 7
    {
        pg8::Gemm g{HB, (const bf16_t*)(p.ws + OFF_WIN0), MR, 6144, 1024};
        EpiIn0 E{(bf16_t*)(p.ws + OFF_R2), (bf16_t*)(p.ws + OFF_R3)};
        SEpiIn0 Es{(bf16_t*)(p.ws + OFF_R2), (bf16_t*)(p.ws + OFF_R3)};
        small_gemm(HB + (size_t)MR * 1024, g.Bt, 6144, 1024, Es);
        S.init(MR, 6144, G, c); pg8::gemm_phase(lds, g, S, E);
        float* z = (float*)(p.ws + OFF_HSS);
        for (int i = blockIdx.x * 512 + threadIdx.x; i < 4 * MP; i += gridDim.x * 512) z[i] = 0.f;
    }
    xcd_barrier(xb);
    mixer0_phase(p, smem, DUP == 6 ? 1 : 2, false);
    xcd_barrier(xb);
    {
        pg8::Gemm g{HB, (const bf16_t*)(p.ws + OFF_WIN0), MR, 6144, 1024};
        EpiIn0 E{(bf16_t*)(p.ws + OFF_R2), (bf16_t*)(p.ws + OFF_R3)};
        SEpiIn0 Es{(bf16_t*)(p.ws + OFF_R2), (bf16_t*)(p.ws + OFF_R3)};
        small_gemm(HB + (size_t)MR * 1024, g.Bt, 6144, 1024, Es);
        S.init(MR, 6144, G, c); pg8::gemm_phase(lds, g, S, E);
        float* z = (float*)(p.ws + OFF_HSS);
        for (int i = blockIdx.x * 512 + threadIdx.x; i < 4 * MP; i += gridDim.x * 512) z[i] = 0.f;
    }
    xcd_barrier(xb);
    mixer0_phase(p, smem, 3, false);
    xcd_barrier(xb);
#endif
    headnorm_phase(p);
    xcd_barrier(xb);
    {
        pg8::Gemm g{(const bf16_t*)(p.ws + OFF_R3), (const bf16_t*)(p.ws + OFF_WOUT0), MR, 1024, 2048};
        EpiRes<0> E{H, HB, SS + 0 * MP, p.x, p.meta};
        SEpiRes<0> Es{H, HB, SS + 0 * MP, p.meta};
        small_gemm(g.A + (size_t)MR * 2048, g.Bt, 1024, 2048, Es);
        S.init(MR, 1024, G, c); pg8::gemm_phase(lds, g, S, E);
    }
    xcd_barrier(xb);
    {
        pg8::Gemm g{HB, (const bf16_t*)(p.ws + OFF_WM10), MR, 4096, 1024};
        EpiUp E{HID, SS + 0 * MP};
        SEpiUp Es{HID, SS + 0 * MP};
        small_gemm(HB + (size_t)MR * 1024, g.Bt, 4096, 1024, Es);
        S.init(MR, 4096, G, c); pg8::gemm_phase(lds, g, S, E);
#if DUP == 3
        xcd_barrier(xb);
        S.init(MR, 4096, G, c); pg8::gemm_phase(lds, g, S, E);
#endif
    }
    xcd_barrier(xb);
    {
        pg8::Gemm g{HID, (const bf16_t*)(p.ws + OFF_WM20), MR, 1024, 4096};
        EpiRes<1> E{H, HB, SS + 1 * MP, nullptr, nullptr};
        SEpiRes<1> Es{H, HB, SS + 1 * MP, nullptr};
        small_gemm(HID + (size_t)MR * 4096, g.Bt, 1024, 4096, Es);
        S.init(MR, 1024, G, c); pg8::gemm_phase(lds, g, S, E);
    }
    xcd_barrier(xb);
    {
        pg8::Gemm g{HB, (const bf16_t*)(p.ws + OFF_WIN1), MR, 2048, 1024};
        EpiQK E{(bf16_t*)(p.ws + OFF_QK1), SS + 1 * MP, (const float*)(p.ws + OFF_ROPE)};
        SEpiQKV Es{(bf16_t*)(p.ws + OFF_QK1), (bf16_t*)(p.ws + OFF_VT), SS + 1 * MP, (const float*)(p.ws + OFF_ROPE)};
        small_gemm(HB + (size_t)MR * 1024, g.Bt, 3072, 1024, Es);
        {
            bf16_t* QKz = (bf16_t*)(p.ws + OFF_QK1); bf16_t* VTz = (bf16_t*)(p.ws + OFF_VT);
            for (int i = blockIdx.x * 512 + threadIdx.x; i < 48 * 128; i += gridDim.x * 512)
                *(u32x4*)(QKz + (size_t)(MR + 16 + (i >> 7)) * 2048 + 1024 + (i & 127) * 8) = (u32x4){0u, 0u, 0u, 0u};
            for (int i = blockIdx.x * 512 + threadIdx.x; i < 1024 * 6; i += gridDim.x * 512)
                *(u32x4*)(VTz + (size_t)(i / 6) * MP + MR + 16 + (i % 6) * 8) = (u32x4){0u, 0u, 0u, 0u};
        }
        S.init(MR, 2048, G, c); pg8::gemm_phase(lds, g, S, E);
        pg8::Gemm g2{(const bf16_t*)(p.ws + OFF_WIN1) + 2048ull * 1024, HB, 1024, MR, 1024};
        EpiVT E2{(bf16_t*)(p.ws + OFF_VT), SS + 1 * MP};
        S.init(1024, MR, G, c); pg8::gemm_phase(lds, g2, S, E2);
    }
    xcd_barrier(xb);
    attn_phase(p, smem);
    xcd_barrier(xb);
#if DUP == 1
    attn_phase(p, smem);
    xcd_barrier(xb);
#endif
    {
        pg8::Gemm g{(const bf16_t*)(p.ws + OFF_AO), (const bf16_t*)(p.ws + OFF_WOUT1), MR, 1024, 1024};
        EpiRes<1> E{H, HB, SS + 2 * MP, nullptr, nullptr};
        S.init(MR, 1024, G, c); pg8::gemm_phase(lds, g, S, E);
    }
    xcd_barrier(xb);
    {
        pg8::Gemm g{HB, (const bf16_t*)(p.ws + OFF_WM11), MR, 4096, 1024};
        EpiUp E{HID, SS + 2 * MP};
        S.init(MR, 4096, G, c); pg8::gemm_phase(lds, g, S, E);
    }
    xcd_barrier(xb);
    {
        pg8::Gemm g{HID, (const bf16_t*)(p.ws + OFF_WM21), MR, 1024, 4096};
        EpiRes<1, false> E{H, HB, SS + 3 * MP, nullptr, nullptr};
        S.init(MR, 1024, G, c); pg8::gemm_phase(lds, g, S, E);
    }
    xcd_barrier(xb);
#if DUP == 8
#pragma unroll 1
    for (int i = 0; i < 20; ++i) xcd_barrier(xb);
#endif
    final_phase(p);
#if DUP == 5
    xcd_barrier(xb);
    {
        pg8::Gemm g{HID, (const bf16_t*)(p.ws + OFF_WM21), MR, 1024, 4096};
        EpiRes<1> E{H, HB, SS + 3 * MP, nullptr, nullptr};
        S.init(MR, 1024, G, c); pg8::gemm_phase(lds, g, S, E);
    }
#endif
}

extern "C" void kernel_launch(void* const* d_in, const int* in_sizes, int n_in, void* d_out, int out_size, void* d_ws, size_t ws_size, hipStream_t stream) {
    static int grid_blocks = 0;
    if (!grid_blocks) {
        int dev = 0, cus = 0, per_cu = 0;
        hipGetDevice(&dev);
        hipDeviceGetAttribute(&cus, hipDeviceAttributeMultiprocessorCount, dev);
        hipFuncSetAttribute((const void*)fwd_megakernel, hipFuncAttributeMaxDynamicSharedMemorySize, LDS_BYTES);
        hipOccupancyMaxActiveBlocksPerMultiprocessor(&per_cu, fwd_megakernel, 512, LDS_BYTES);
        if (per_cu < 1) per_cu = 1;
        grid_blocks = cus * per_cu;
        if (grid_blocks > 256) grid_blocks = 256;
    }
    Params p{};
    const float** f = (const float**)&p;
    for (int i = 0; i < 22; ++i) f[i] = (const float*)d_in[i];
    p.out = (float*)d_out;
    p.ws = (unsigned char*)d_ws;
    void* args[] = {&p};
    (void)hipMemsetAsync((unsigned char*)d_ws + OFF_BAR, 0, XCD_BAR_WORDS * sizeof(unsigned), stream);
    hipError_t e = hipLaunchCooperativeKernel((const void*)fwd_megakernel, dim3(grid_blocks), dim3(512), args, LDS_BYTES, stream);
    if (e != hipSuccess) fprintf(stderr, "cooperative launch failed: %s (grid %d)\n", hipGetErrorString(e), grid_blocks);
}
```
